# Optimizing an MI355X kernel written in HIP

```python
import math
import jax
import jax.numpy as jnp
from jax import lax
import numpy as np

D_MODEL = 1024
BATCH = 32
SEQ = 256
DEPTH = 4
DEC_BATCH = 4
DEC_SEQ = 2048
PAST_LEN = 256

GRID_W = 64
D_MIX = D_MODEL
W_GROUP = D_MIX // 4
H_RET = 4
DK_RET = W_GROUP // H_RET
W_HY = W_GROUP
HY_EMB = 33
HY_HIDDEN = 64
HY_DECAY_TARGET = 1e-2
HY_FAST_PCT = 0.3
HY_SLOW_PCT = 1.5
H_GDN = 4
DK_GDN = W_GROUP // H_GDN
DV_GDN = W_GROUP // H_GDN
W_GDN = H_GDN * DV_GDN
H_SSD = 4
P_SSD = W_GROUP // H_SSD
W_SSD = H_SSD * P_SSD
G_SSD = 2
N_SSD = 128
SHORT_CONV = 3
CHUNK = 64
D_FF = 4 * D_MODEL
ROPE_BASE = 10000.0
EPS = 1e-6
RET_COLS = 4 * W_GROUP
HY_COLS = 3 * W_HY
GDN_COLS = 4 * W_GDN + 4 * H_GDN
SSD_COLS = 2 * W_SSD + 2 * G_SSD * N_SSD + 2 * H_SSD
IN_COLS = RET_COLS + HY_COLS + GDN_COLS + SSD_COLS
SPLITS = (RET_COLS, RET_COLS + HY_COLS, RET_COLS + HY_COLS + GDN_COLS)

kernel_name = "hybrid_parallel_groups_diffusion_step"


def rms_norm(x, w):
    xf = x.astype(jnp.float32)
    y = xf * lax.rsqrt(jnp.mean(xf * xf, axis=-1, keepdims=True) + EPS)
    return (y * w.astype(jnp.float32)).astype(x.dtype)


def head_rms(o, w):
    h, d = o.shape[-2:]
    return rms_norm(o, w.reshape(h, d)).reshape(*o.shape[:-2], h * d)


def l2norm(x):
    xf = x.astype(jnp.float32)
    return (xf * lax.rsqrt(jnp.sum(xf * xf, axis=-1, keepdims=True) + EPS)).astype(x.dtype)


def _rev(t):
    return jnp.flip(t, axis=1)


def centred_conv(x, w, b=None):
    k_w = w.shape[0]
    pad = k_w // 2
    length = x.shape[1]
    xp = jnp.pad(x, ((0, 0), (pad, pad), (0, 0)))
    y = xp[:, 0:length] * w[0]
    for i in range(1, k_w):
        y = y + xp[:, i:i + length] * w[i]
    return y if b is None else y + b


def axial_rope(n_tok):
    rows = n_tok // GRID_W
    r = jnp.repeat(jnp.arange(rows), GRID_W).astype(jnp.float32)
    col = jnp.tile(jnp.arange(GRID_W), rows).astype(jnp.float32)
    quarter = DK_RET // 4
    inv = ROPE_BASE ** (-jnp.arange(quarter, dtype=jnp.float32) / quarter)
    ang = jnp.concatenate([r[:, None] * inv, col[:, None] * inv], axis=-1)
    return jnp.cos(ang), jnp.sin(ang)


def apply_rope(x, cos, sin):
    x1, x2 = jnp.split(x, 2, axis=-1)
    c = cos[None, :, None, :]
    s = sin[None, :, None, :]
    return jnp.concatenate([x1 * c - x2 * s, x1 * s + x2 * c], axis=-1).astype(x.dtype)


def _to_chunks(t):
    b, length, h = t.shape[:3]
    t = t.astype(jnp.float32).reshape(b, length // CHUNK, CHUNK, h, *t.shape[3:])
    return jnp.moveaxis(jnp.moveaxis(t, 1, 0), 3, 2)


def _from_chunks(o):
    n, b, h, c, v = o.shape
    return jnp.swapaxes(jnp.moveaxis(o, 0, 1), 2, 3).reshape(b, n * c, h, v)


def decay_scan(q, k, v, log_a, s0):
    incl = jnp.tril(jnp.ones((CHUNK, CHUNK), dtype=bool))

    def step(S, inp):
        qc, kc, vc, gc = inp
        cum = jnp.cumsum(gc, axis=-1)
        dec = jnp.exp(jnp.where(incl, cum[..., :, None] - cum[..., None, :], -jnp.inf))
        att = jnp.einsum('bhik,bhjk->bhij', qc, kc) * dec
        o = (jnp.einsum('bhij,bhjv->bhiv', att, vc)
             + jnp.einsum('bhck,bhkv->bhcv', qc * jnp.exp(cum)[..., None], S))
        last = cum[..., -1:]
        S = (jnp.exp(last)[..., None] * S
             + jnp.einsum('bhck,bhcv->bhkv', kc * jnp.exp(last - cum)[..., None], vc))
        return S, o

    S, o = lax.scan(step, s0.astype(jnp.float32),
                    (_to_chunks(q), _to_chunks(k), _to_chunks(v), _to_chunks(log_a)))
    return _from_chunks(o).astype(v.dtype), S.astype(v.dtype)


def gated_delta_scan(q, k, v, log_a, beta, s0):
    dk = q.shape[-1]
    incl = jnp.tril(jnp.ones((CHUNK, CHUNK), dtype=bool))
    strict = jnp.tril(jnp.ones((CHUNK, CHUNK), dtype=bool), -1)
    eye = jnp.eye(CHUNK, dtype=jnp.float32)

    def step(S, inp):
        qc, kc, vc, gc, bc = inp
        cum = jnp.cumsum(gc, axis=-1)
        dec = jnp.exp(jnp.where(incl, cum[..., :, None] - cum[..., None, :], -jnp.inf))
        a_mat = jnp.where(strict, dec * jnp.einsum('bhik,bhjk->bhij', kc, kc), 0.0) * bc[..., :, None]
        rhs = jnp.concatenate([kc * (bc * jnp.exp(cum))[..., None], vc * bc[..., None]], axis=-1)
        sol = lax.linalg.triangular_solve(a_mat + eye, rhs, left_side=True, lower=True,
                                          unit_diagonal=True)
        w_c, u_c = sol[..., :dk], sol[..., dk:]
        v_new = u_c - jnp.einsum('bhck,bhkv->bhcv', w_c, S)
        att = jnp.einsum('bhik,bhjk->bhij', qc, kc) * dec
        o = (jnp.einsum('bhck,bhkv->bhcv', qc * jnp.exp(cum)[..., None], S)
             + jnp.einsum('bhij,bhjv->bhiv', att, v_new))
        last = cum[..., -1:]
        S = (jnp.exp(last)[..., None] * S
             + jnp.einsum('bhck,bhcv->bhkv', kc * jnp.exp(last - cum)[..., None], v_new))
        return S, o

    S, o = lax.scan(step, s0.astype(jnp.float32),
                    (_to_chunks(q), _to_chunks(k), _to_chunks(v), _to_chunks(log_a), _to_chunks(beta)))
    return _from_chunks(o).astype(v.dtype), S.astype(v.dtype)


def retention_mixer(p, log_decay, norm_w, s0, rope):
    b, length, _ = p.shape
    q, k, v, g = jnp.split(p, 4, axis=-1)
    q = q.reshape(b, length, H_RET, DK_RET)
    k = k.reshape(b, length, H_RET, DK_RET) * (DK_RET ** -0.5)
    v = v.reshape(b, length, H_RET, DK_RET)
    if rope is not None:
        q = apply_rope(q, rope[0], rope[1])
        k = apply_rope(k, rope[0], rope[1])
    la = jnp.broadcast_to(log_decay, (b, length, 2, H_RET))
    o_f, s_f = decay_scan(q, k, v, la[:, :, 0], s0[:, 0])
    o_b, s_b = decay_scan(_rev(q), _rev(k), _rev(v), la[:, :, 1], s0[:, 1])
    o = head_rms(o_f + _rev(o_b), norm_w) * jax.nn.silu(g)
    return o, jnp.stack([s_f, s_b], axis=1)


def hyena_filter(length, freq, w1, b1, w2, b2, w3):
    t = jnp.linspace(0.0, 1.0, length, dtype=jnp.float32)[:, None]
    bands = (HY_EMB - 1) // 2
    w = 2.0 * math.pi * jnp.arange(length, dtype=jnp.float32)[:, None] / length
    f = jnp.linspace(1e-4, bands - 1, bands, dtype=jnp.float32)[None, :]
    z = jnp.concatenate([t, jnp.cos(f * w), -jnp.sin(f * w)], axis=-1)
    hdn = jnp.sin(freq * (z @ w1 + b1))
    hdn = jnp.sin(freq * (hdn @ w2 + b2))
    taps = (hdn @ w3).astype(jnp.float32).reshape(length, 2, W_HY)
    deltas = jnp.abs(jnp.linspace(math.log(HY_DECAY_TARGET) / HY_SLOW_PCT,
                                  math.log(HY_DECAY_TARGET) / HY_FAST_PCT, W_HY, dtype=jnp.float32))
    return taps * jnp.exp(-t * deltas)[:, None, :]


def bidir_long_conv(u, taps, bias):
    length = u.shape[1]
    circ_taps = jnp.concatenate([taps[:, 0], jnp.zeros_like(taps[:1, 0]), taps[:0:-1, 1]], axis=0)
    u_f = jnp.fft.rfft(u.astype(jnp.float32), n=2 * length, axis=1)
    t_f = jnp.fft.rfft(circ_taps, n=2 * length, axis=0)
    y = jnp.fft.irfft(u_f * t_f[None], n=2 * length, axis=1)[:, :length]
    return (y + u * bias).astype(u.dtype)


def hyena_mixer(p, conv_w, conv_b, taps, bias, norm_w):
    x0, x1, v = jnp.split(centred_conv(p, conv_w, conv_b), 3, axis=-1)
    y = x0 * bidir_long_conv(v * x1, taps, bias)
    return rms_norm(y, norm_w)


def gdn_mixer(p, conv_w, a_log, dt_bias, norm_w, s0):
    b, length, _ = p.shape
    qkv, z, a, bb = jnp.split(p, (3 * W_GDN, 4 * W_GDN, 4 * W_GDN + 2 * H_GDN), axis=-1)
    q, k, v = jnp.split(jax.nn.silu(centred_conv(qkv, conv_w)), 3, axis=-1)
    q = l2norm(q.reshape(b, length, H_GDN, DK_GDN)) * (DK_GDN ** -0.5)
    k = l2norm(k.reshape(b, length, H_GDN, DK_GDN))
    v = v.reshape(b, length, H_GDN, DV_GDN)
    log_a = -jnp.exp(a_log) * jax.nn.softplus(a.reshape(b, length, 2, H_GDN) + dt_bias)
    beta = jax.nn.sigmoid(bb.reshape(b, length, 2, H_GDN))
    o_f, s_f = gated_delta_scan(q, k, v, log_a[:, :, 0], beta[:, :, 0], s0[:, 0])
    o_b, s_b = gated_delta_scan(_rev(q), _rev(k), _rev(v), _rev(log_a[:, :, 1]),
                                _rev(beta[:, :, 1]), s0[:, 1])
    o = head_rms(o_f + _rev(o_b), norm_w) * jax.nn.silu(z)
    return o, jnp.stack([s_f, s_b], axis=1)


def ssd_mixer(p, conv_w, conv_b, a_log, dt_bias, d_skip, norm_w, s0):
    b, length, _ = p.shape
    gn = G_SSD * N_SSD
    xbc, z, dt = jnp.split(p, (W_SSD + 2 * gn, 2 * W_SSD + 2 * gn), axis=-1)
    xs, bm, cm = jnp.split(jax.nn.silu(centred_conv(xbc, conv_w, conv_b)), (W_SSD, W_SSD + gn), axis=-1)
    xs = xs.reshape(b, length, H_SSD, P_SSD)
    bm = jnp.repeat(bm.reshape(b, length, G_SSD, N_SSD), H_SSD // G_SSD, axis=2)
    cm = jnp.repeat(cm.reshape(b, length, G_SSD, N_SSD), H_SSD // G_SSD, axis=2)
    dt = jax.nn.softplus(dt.reshape(b, length, 2, H_SSD) + dt_bias)
    log_a = dt * -jnp.exp(a_log)
    xdt = xs[:, :, None] * dt[..., None]
    y_f, s_f = decay_scan(cm, bm, xdt[:, :, 0], log_a[:, :, 0], s0[:, 0])
    y_b, s_b = decay_scan(_rev(cm), _rev(bm), _rev(xdt[:, :, 1]), _rev(log_a[:, :, 1]), s0[:, 1])
    y = (y_f + _rev(y_b) + xs * d_skip[:, None]).reshape(b, length, W_SSD) * jax.nn.silu(z)
    y = rms_norm(y.reshape(b, length, G_SSD, W_SSD // G_SSD),
                 norm_w.reshape(G_SSD, W_SSD // G_SSD)).reshape(b, length, W_SSD)
    return y, jnp.stack([s_f, s_b], axis=1)


def layer(x, mod, s_ret, s_gdn, s_ssd, rope, lw):
    length = x.shape[1]
    sh1, sc1, g1, sh2, sc2, g2 = jnp.split(mod[:, None, :], 6, axis=-1)
    h = rms_norm(x, lw['norm1']) * (1 + sc1) + sh1
    p_ret, p_hy, p_gdn, p_ssd = jnp.split(h @ lw['w_in'], SPLITS, axis=-1)
    o_ret, f_ret = retention_mixer(p_ret, lw['ret_log_decay'], lw['ret_norm'], s_ret, rope)
    taps = hyena_filter(length, lw['hy_freq'], lw['hy_w1'], lw['hy_b1'], lw['hy_w2'], lw['hy_b2'], lw['hy_w3'])
    o_hy = hyena_mixer(p_hy, lw['hy_conv_w'], lw['hy_conv_b'], taps, lw['hy_bias'], lw['hy_norm'])
    o_gdn, f_gdn = gdn_mixer(p_gdn, lw['gdn_conv_w'], lw['gdn_A_log'], lw['gdn_dt_bias'], lw['gdn_norm'], s_gdn)
    o_ssd, f_ssd = ssd_mixer(p_ssd, lw['ssd_conv_w'], lw['ssd_conv_b'], lw['ssd_A_log'], lw['ssd_dt_bias'],
                             lw['ssd_D'], lw['ssd_norm'], s_ssd)
    mixed = jnp.concatenate([o_ret, o_hy, o_gdn, o_ssd], axis=-1)
    x = x + g1 * (mixed @ lw['w_out'])
    h2 = rms_norm(x, lw['norm2']) * (1 + sc2) + sh2
    x = x + g2 * (jnp.square(jax.nn.relu(h2 @ lw['mlp_w1'])) @ lw['mlp_w2'])
    return x, f_ret, f_gdn, f_ssd


def trunk(x, cond, st_ret, st_gdn, st_ssd, rope, layers, final_norm_w):
    finals = []
    for l in range(DEPTH):
        lw = layers[l]
        mod = jax.nn.silu(cond) @ lw['w_mod'] + lw['b_mod']
        x, f_ret, f_gdn, f_ssd = layer(x, mod, st_ret[:, l], st_gdn[:, l], st_ssd[:, l], rope, lw)
        finals.append((f_ret, f_gdn, f_ssd))
    return rms_norm(x, final_norm_w), finals


def setup_inputs(seed: int = 0) -> dict:
    key = jax.random.key(seed)
    keys = jax.random.split(key, 64)
    counter = [0]

    def nk():
        counter[0] += 1
        return keys[counter[0] - 1]

    def nrm(shape, scale=1.0):
        return scale * jax.random.normal(nk(), shape, jnp.float32)

    def gain(shape):
        return 1.0 + 0.02 * jax.random.normal(nk(), shape, jnp.float32)

    def loguni(shape, lo, hi):
        return jnp.exp(jax.random.uniform(nk(), shape, jnp.float32, math.log(lo), math.log(hi)))

    def inv_softplus_dt(shape):
        dt = loguni(shape, 1e-3, 1e-1)
        return dt + jnp.log(-jnp.expm1(-dt))

    ret_base = jnp.log(1.0 - 2.0 ** (-5.0 - jnp.arange(H_RET, dtype=jnp.float32)))
    return {
        'x_prompt': nrm((BATCH, SEQ, D_MODEL)),
        'x_sample': nrm((DEC_BATCH, DEC_SEQ, D_MODEL)),
        'state_ret': nrm((DEC_BATCH, DEPTH, 2, H_RET, DK_RET, DK_RET), 0.1),
        'state_gdn': nrm((DEC_BATCH, DEPTH, 2, H_GDN, DK_GDN, DV_GDN), 0.1),
        'state_ssd': nrm((DEC_BATCH, DEPTH, 2, H_SSD, N_SSD, P_SSD), 0.1),
        'c': nrm((DEC_BATCH, D_MODEL)),
        'c_ctx': nrm((D_MODEL,)),
        'norm1_w': gain((DEPTH, D_MODEL)),
        'norm2_w': gain((DEPTH, D_MODEL)),
        'w_mod': nrm((DEPTH, D_MODEL, 6 * D_MODEL), 0.5 * D_MODEL ** -0.5),
        'b_mod': nrm((DEPTH, 6 * D_MODEL), 0.01),
        'w_in': nrm((DEPTH, D_MODEL, IN_COLS), D_MODEL ** -0.5),
        'w_out': nrm((DEPTH, D_MIX, D_MODEL), D_MIX ** -0.5),
        'ret_log_decay': ret_base * (1.0 + 0.05 * jax.random.normal(nk(), (DEPTH, 2, H_RET), jnp.float32)),
        'ret_norm_w': gain((DEPTH, W_GROUP)),
        'hy_conv_w': nrm((DEPTH, SHORT_CONV, HY_COLS), SHORT_CONV ** -0.5),
        'hy_conv_b': nrm((DEPTH, HY_COLS), 0.01),
        'hy_freq': gain((DEPTH, HY_HIDDEN)),
        'hy_w1': nrm((DEPTH, HY_EMB, HY_HIDDEN), HY_EMB ** -0.5),
        'hy_b1': nrm((DEPTH, HY_HIDDEN), 0.1),
        'hy_w2': nrm((DEPTH, HY_HIDDEN, HY_HIDDEN), HY_HIDDEN ** -0.5),
        'hy_b2': nrm((DEPTH, HY_HIDDEN), 0.1),
        'hy_w3': nrm((DEPTH, HY_HIDDEN, 2 * W_HY), HY_HIDDEN ** -0.5),
        'hy_bias': nrm((DEPTH, W_HY)),
        'hy_norm_w': gain((DEPTH, W_HY)),
        'gdn_conv_w': nrm((DEPTH, SHORT_CONV, 3 * W_GDN), SHORT_CONV ** -0.5),
        'gdn_A_log': jnp.log(jax.random.uniform(nk(), (DEPTH, 2, H_GDN), jnp.float32, 1.0, 16.0)),
        'gdn_dt_bias': inv_softplus_dt((DEPTH, 2, H_GDN)),
        'gdn_norm_w': gain((DEPTH, W_GDN)),
        'ssd_conv_w': nrm((DEPTH, SHORT_CONV, W_SSD + 2 * G_SSD * N_SSD), SHORT_CONV ** -0.5),
        'ssd_conv_b': nrm((DEPTH, W_SSD + 2 * G_SSD * N_SSD), 0.01),
        'ssd_A_log': jnp.log(jax.random.uniform(nk(), (DEPTH, 2, H_SSD), jnp.float32, 1.0, 16.0)),
        'ssd_dt_bias': inv_softplus_dt((DEPTH, 2, H_SSD)),
        'ssd_D': gain((DEPTH, H_SSD)),
        'ssd_norm_w': gain((DEPTH, W_SSD)),
        'mlp_w1': nrm((DEPTH, D_MODEL, D_FF), D_MODEL ** -0.5),
        'mlp_w2': nrm((DEPTH, D_FF, D_MODEL), D_FF ** -0.5),
        'final_norm_w': gain((D_MODEL,)),
    }


def reference(x_prompt, x_sample, state_ret, state_gdn, state_ssd, c, c_ctx,
              norm1_w, norm2_w, w_mod, b_mod, w_in, w_out,
              ret_log_decay, ret_norm_w,
              hy_conv_w, hy_conv_b, hy_freq, hy_w1, hy_b1, hy_w2, hy_b2, hy_w3, hy_bias, hy_norm_w,
              gdn_conv_w, gdn_A_log, gdn_dt_bias, gdn_norm_w,
              ssd_conv_w, ssd_conv_b, ssd_A_log, ssd_dt_bias, ssd_D, ssd_norm_w,
              mlp_w1, mlp_w2, final_norm_w):
    layers = [dict(
        norm1=norm1_w[l], norm2=norm2_w[l], w_mod=w_mod[l], b_mod=b_mod[l],
        w_in=w_in[l], w_out=w_out[l],
        ret_log_decay=ret_log_decay[l], ret_norm=ret_norm_w[l],
        hy_conv_w=hy_conv_w[l], hy_conv_b=hy_conv_b[l], hy_freq=hy_freq[l],
        hy_w1=hy_w1[l], hy_b1=hy_b1[l], hy_w2=hy_w2[l], hy_b2=hy_b2[l], hy_w3=hy_w3[l],
        hy_bias=hy_bias[l], hy_norm=hy_norm_w[l],
        gdn_conv_w=gdn_conv_w[l], gdn_A_log=gdn_A_log[l], gdn_dt_bias=gdn_dt_bias[l], gdn_norm=gdn_norm_w[l],
        ssd_conv_w=ssd_conv_w[l], ssd_conv_b=ssd_conv_b[l], ssd_A_log=ssd_A_log[l],
        ssd_dt_bias=ssd_dt_bias[l], ssd_D=ssd_D[l], ssd_norm=ssd_norm_w[l],
        mlp_w1=mlp_w1[l], mlp_w2=mlp_w2[l]) for l in range(DEPTH)]

    bsz = x_prompt.shape[0]
    dt = x_prompt.dtype
    z_ret = jnp.zeros((bsz, DEPTH, 2, H_RET, DK_RET, DK_RET), dt)
    z_gdn = jnp.zeros((bsz, DEPTH, 2, H_GDN, DK_GDN, DV_GDN), dt)
    z_ssd = jnp.zeros((bsz, DEPTH, 2, H_SSD, N_SSD, P_SSD), dt)
    y_prompt, ctx_finals = trunk(x_prompt, c_ctx[None, :], z_ret, z_gdn, z_ssd, None, layers, final_norm_w)
    new_state_ret = jnp.stack([f[0] for f in ctx_finals], axis=1)
    new_state_gdn = jnp.stack([f[1] for f in ctx_finals], axis=1)
    new_state_ssd = jnp.stack([f[2] for f in ctx_finals], axis=1)

    rope = axial_rope(x_sample.shape[1])
    y_sample, _ = trunk(x_sample, c, state_ret, state_gdn, state_ssd, rope, layers, final_norm_w)

    return (y_prompt, y_sample, new_state_ret, new_state_gdn, new_state_ssd)
```

```cpp
#include <hip/hip_runtime.h>
#include <hip/hip_cooperative_groups.h>
#include <cstdio>
namespace cg = cooperative_groups;
namespace pg8 {
#define PG8_LAS __attribute__((address_space(3)))
typedef unsigned short bf16_t;
typedef short bf16x8 __attribute__((ext_vector_type(8)));
typedef float f32x4 __attribute__((ext_vector_type(4)));
typedef unsigned u32x4 __attribute__((ext_vector_type(4)));
constexpr int BM = 256, BK = 64, HALF = 128, HTB = HALF * BK * 2  , STAGE_BYTES = 8 * HTB, NXCD = 8, WGM = 8;

__host__ __device__ __forceinline__ int lds_byte(int r, int c) { const int st = (r >> 4) * 2 + (c >> 5), rr = r & 15, cc = c & 31, ob = rr * 64 + cc * 2; return st * 1024 + (ob ^ (((ob >> 9) & 1) << 5)); }
__host__ __device__ __forceinline__ void stage_rc(int b, int& R, int& C) { const int st = b / 1024, sb = b % 1024, swz = sb ^ (((sb >> 9) & 1) << 5); R = (st >> 1) * 16 + swz / 64; C = (st & 1) * 32 + (swz % 64) / 2; }
__host__ __device__ __forceinline__ int perm32(int rho) { const int n = rho >> 4, i = rho & 15; return 8 * (i >> 2) + 4 * n + (i & 3); }

struct Unit { int pm, pn; };
struct Gemm { const bf16_t* A; const bf16_t* Bt; int M, N, K; };

struct StaticOrder {
    int nM, nN, nwg, G, c;
    __host__ __device__ void init(int M, int N, int G_, int c_) { nM = M / BM; nN = N / BM; nwg = nM * nN; G = G_; c = c_; }
    __host__ __device__ bool next(int i, Unit& u) const {
        const long L = (long)i * G + c; if (L >= nwg) return false;
        int wgid = (int)L; { const int q = nwg / NXCD, r = nwg % NXCD, xcd = wgid % NXCD, off = wgid / NXCD; wgid = (xcd < r ? xcd * (q + 1) : r * (q + 1) + (xcd - r) * q) + off; }
        const int nig = WGM * nN, gid = wgid / nig, fm = gid * WGM, gsz = (nM - fm) < WGM ? (nM - fm) : WGM;
        u.pm = fm + ((wgid % nig) % gsz); u.pn = (wgid % nig) / gsz; return true;
    }
    __device__ __forceinline__ void a_ready(const Unit&) const {}
    __device__ __forceinline__ void done(const Unit&) const {}
};
__device__ __forceinline__ unsigned cvt_pk_bf16(float lo, float hi) { unsigned r; asm volatile("v_cvt_pk_bf16_f32 %0, %1, %2" : "=v"(r) : "v"(lo), "v"(hi)); return r; }

template <class Epi, class Sched, bool STAMP = false>
__device__ __forceinline__ void gemm_phase(PG8_LAS unsigned char* lds, const Gemm g, const Sched& S, const Epi& E, unsigned long long* stamps) {
    int tid_l = threadIdx.x; asm volatile("" : "+v"(tid_l));
    const int tid = tid_l, wid = __builtin_amdgcn_readfirstlane(tid >> 6), lane = tid & 63, wr = wid >> 2, wc = wid & 3, fr = lane & 15, fq = lane >> 4;
    const int K = g.K, nt = K / BK;
    int ts_lo = 0, ts_hi = 0, nts = 0; const unsigned long long rt_entry = STAMP ? (unsigned long long)wall_clock64() : 0ull;
#define PG8_STAMP() do { if (STAMP && wid == 0 && nts < 64) { const unsigned long long _c = (unsigned long long)clock64(); \
        ts_lo = (lane == nts) ? (int)(unsigned)_c : ts_lo; ts_hi = (lane == nts) ? (int)(unsigned)(_c >> 32) : ts_hi; ++nts; } } while (0)
    PG8_STAMP();
    unsigned voffA[2], voffB[2];
#pragma unroll
    for (int i = 0; i < 2; ++i) { int R, C; stage_rc(tid * 16 + i * 8192, R, C); const int Rb = Epi::PERM ? ((R & ~31) + perm32(R & 31)) : R;
        voffA[i] = (unsigned)(R * K + C) * 2u; voffB[i] = (unsigned)(Rb * K + C) * 2u; }
    const size_t kstep = (size_t)(BK * 2);
    const size_t hstep = (size_t)HALF * K * 2;
    const size_t tstep = 2 * hstep;
    const unsigned ldsw = (unsigned)wid * 1024u;
    const int aoff = lds_byte(wr * 64 + fr, fq * 8), boff = lds_byte(wc * 32 + fr, fq * 8);
#define PG8_SA(b, h) (((b) * 2 + (h)) * HTB)
#define PG8_SB(b, h) ((4 + (b) * 2 + (h)) * HTB)
#define PG8_STAGE(bufoff, gbase, voff) do { _Pragma("unroll") for (int _i = 0; _i < 2; ++_i) \
        __builtin_amdgcn_global_load_lds((const unsigned*)((const char*)(gbase) + (voff)[_i]), (PG8_LAS unsigned*)(lds + (bufoff) + ldsw + _i * 8192), 16, 0, 0); } while (0)
#define PG8_LDA(dst, b, h) do { _Pragma("unroll") for (int m = 0; m < 4; ++m) _Pragma("unroll") for (int k = 0; k < 2; ++k) dst[m][k] = *(const PG8_LAS bf16x8*)(lds + PG8_SA(b, h) + aoff + m * 2048 + k * 1024); } while (0)
#define PG8_LDB(dst, b, h) do { _Pragma("unroll") for (int n = 0; n < 2; ++n) _Pragma("unroll") for (int k = 0; k < 2; ++k) dst[n][k] = *(const PG8_LAS bf16x8*)(lds + PG8_SB(b, h) + boff + n * 2048 + k * 1024); } while (0)
#define PG8_MMA(ai, bj, At, Bt) do { __builtin_amdgcn_s_setprio(1); _Pragma("unroll") for (int m = 0; m < 4; ++m) _Pragma("unroll") for (int n = 0; n < 2; ++n) _Pragma("unroll") for (int k = 0; k < 2; ++k) \
        acc[ai][bj][m][n] = __builtin_amdgcn_mfma_f32_16x16x32_bf16(Bt[n][k], At[m][k], acc[ai][bj][m][n], 0, 0, 0); __builtin_amdgcn_s_setprio(0); } while (0)
#define PG8_WAIT_V(n) asm volatile("s_waitcnt vmcnt(" #n ")" ::: "memory")
#define PG8_WAIT_L(n) asm volatile("s_waitcnt lgkmcnt(" #n ")" ::: "memory")
#define PG8_BAR __builtin_amdgcn_s_barrier()
#define PG8_SCHED __builtin_amdgcn_sched_barrier(0)
    Unit cur, nxt; int ui = 0;
    if (!S.next(0, cur)) return;
    f32x4 acc[2][2][4][2];
#pragma unroll
    for (int a = 0; a < 2; ++a)
#pragma unroll
        for (int b = 0; b < 2; ++b)
#pragma unroll
            for (int m = 0; m < 4; ++m)
#pragma unroll
                for (int n = 0; n < 2; ++n) acc[a][b][m][n] = (f32x4){0.f, 0.f, 0.f, 0.f};
    bf16x8 At[4][2], B0[2][2], B1[2][2];
    const char* cA = (const char*)g.A + (size_t)cur.pm * tstep; const char* cB = (const char*)g.Bt + (size_t)cur.pn * tstep;
    S.a_ready(cur);
    PG8_STAGE(PG8_SB(0, 0), cB, voffB); PG8_STAGE(PG8_SA(0, 0), cA, voffA); PG8_STAGE(PG8_SB(0, 1), cB + hstep, voffB); PG8_STAGE(PG8_SA(0, 1), cA + hstep, voffA);
    if (wr == 1) PG8_BAR;
    PG8_WAIT_V(4); PG8_BAR;
    PG8_STAGE(PG8_SB(1, 0), cB + kstep, voffB); PG8_STAGE(PG8_SA(1, 0), cA + kstep, voffA); PG8_STAGE(PG8_SB(1, 1), cB + hstep + kstep, voffB);
    PG8_WAIT_V(6); PG8_BAR;
    PG8_STAMP();
    for (;;) {
        const bool has_next = S.next(ui + 1, nxt);
        const char* nA = has_next ? (const char*)g.A + (size_t)nxt.pm * tstep : cA; const char* nB = has_next ? (const char*)g.Bt + (size_t)nxt.pn * tstep : cB;
        for (int t = 0; t < nt; t += 2) {
            const bool last = (t == nt - 2);
            const char* a1 = cA + (size_t)(t + 1) * kstep;
            const char* a2 = last ? nA : cA + (size_t)(t + 2) * kstep; const char* b2 = last ? nB : cB + (size_t)(t + 2) * kstep;
            const char* a3 = a2 + kstep; const char* b3 = b2 + kstep;
            if (last && has_next) S.a_ready(nxt);
            PG8_LDB(B0, 0, 0); PG8_SCHED; PG8_LDA(At, 0, 0); PG8_STAGE(PG8_SA(1, 1), a1 + hstep, voffA);
            PG8_WAIT_L(8); PG8_BAR; PG8_WAIT_L(0); PG8_MMA(0, 0, At, B0); PG8_BAR; PG8_SCHED;
            PG8_LDB(B1, 0, 1); PG8_STAGE(PG8_SB(0, 0), b2, voffB);
            PG8_BAR; PG8_WAIT_L(0); PG8_MMA(0, 1, At, B1); PG8_BAR;
            PG8_LDA(At, 0, 1); PG8_STAGE(PG8_SA(0, 0), a2, voffA);
            PG8_BAR; PG8_WAIT_L(0); PG8_MMA(1, 0, At, B0); PG8_BAR; PG8_SCHED;
            PG8_STAGE(PG8_SB(0, 1), b2 + hstep, voffB);
            PG8_WAIT_V(6); PG8_BAR; PG8_MMA(1, 1, At, B1); PG8_BAR;
            PG8_LDB(B0, 1, 0); PG8_SCHED; PG8_LDA(At, 1, 0); PG8_STAGE(PG8_SA(0, 1), a2 + hstep, voffA);
            PG8_WAIT_L(8); PG8_BAR; PG8_WAIT_L(0); PG8_MMA(0, 0, At, B0); PG8_BAR; PG8_SCHED;
            PG8_LDB(B1, 1, 1); PG8_STAGE(PG8_SB(1, 0), b3, voffB);
            PG8_BAR; PG8_WAIT_L(0); PG8_MMA(0, 1, At, B1); PG8_BAR;
            PG8_LDA(At, 1, 1); PG8_STAGE(PG8_SA(1, 0), a3, voffA);
            PG8_BAR; PG8_WAIT_L(0); PG8_MMA(1, 0, At, B0); PG8_BAR; PG8_SCHED;
            PG8_STAGE(PG8_SB(1, 1), b3 + hstep, voffB);
            PG8_WAIT_V(6); PG8_BAR; PG8_MMA(1, 1, At, B1); PG8_BAR;
        }
        PG8_STAMP();
        if constexpr (!Epi::AFTER_DRAIN) { E(acc, cur, wr, wc, fr, fq); S.done(cur); }
        PG8_STAMP();
        if (!has_next) break;
#pragma unroll
        for (int a = 0; a < 2; ++a)
#pragma unroll
            for (int b = 0; b < 2; ++b)
#pragma unroll
                for (int m = 0; m < 4; ++m)
#pragma unroll
                    for (int n = 0; n < 2; ++n) acc[a][b][m][n] = (f32x4){0.f, 0.f, 0.f, 0.f};
        cur = nxt; cA = nA; cB = nB; ++ui;
    }
    PG8_WAIT_V(0);
    if (wr == 0) PG8_BAR;
    PG8_BAR;
    if constexpr (Epi::AFTER_DRAIN) { E.fused(acc, cur, wr, wc, fr, fq, lds, wid, lane); S.done(cur); }
    PG8_STAMP();
    if (STAMP && wid == 0) { stamps[lane] = lane < nts ? (((unsigned long long)(unsigned)ts_hi << 32) | (unsigned)ts_lo) : 0ull;
        if (lane == 62) stamps[62] = rt_entry; if (lane == 63) stamps[63] = (unsigned long long)wall_clock64(); }
#undef PG8_STAMP
#undef PG8_SA
#undef PG8_SB
#undef PG8_STAGE
#undef PG8_LDA
#undef PG8_LDB
#undef PG8_MMA
#undef PG8_WAIT_V
#undef PG8_WAIT_L
#undef PG8_BAR
#undef PG8_SCHED
}
}

using pg8::bf16_t; using pg8::bf16x8; using pg8::f32x4; using pg8::u32x4;
typedef float f32x2v __attribute__((ext_vector_type(2)));
typedef unsigned u32x2 __attribute__((ext_vector_type(2)));

constexpr int T = 16384, TP = 8192, D = 1024, NP = 4096, NL = 4;
constexpr float EPS = 1e-6f;
constexpr int C_RQ = 0, C_RK = 256, C_RV = 512, C_RG = 768, C_HY = 1024;
constexpr int C_GQ = 1792, C_GK = 2048, C_GV = 2304, C_GZ = 2560;
constexpr int C_SX = 2832, C_SB = 3088, C_SC = 3344, C_SZ = 3600;
constexpr int INC = 3864;

constexpr size_t WS_CTR = 0;
constexpr size_t WS_MOD = 4096;
constexpr size_t WS_GATE = WS_MOD + 491520;
constexpr size_t WS_X = WS_GATE + (size_t)T * 32 * 4;
constexpr size_t WS_H = WS_X + (size_t)T * D * 4;
constexpr size_t WS_P = WS_H + (size_t)T * D * 2;
constexpr size_t WS_MIX = WS_P + (size_t)T * NP * 2;
constexpr size_t WS_OB = WS_MIX + (size_t)T * D * 2;
constexpr size_t WS_WIN = WS_OB + (size_t)T * D * 2;
constexpr size_t WS_WOUT = WS_WIN + 8388608;
constexpr size_t WS_W1 = WS_WOUT + 2097152;
constexpr size_t WS_W2 = WS_W1 + 8388608;
constexpr size_t WS_TAPS = WS_W2 + 8388608;
constexpr size_t WS_U = WS_TAPS + 18874368;
constexpr size_t WS_X0 = WS_U + (size_t)T * 256 * 4;
constexpr size_t WS_END = WS_X0 + (size_t)T * 256 * 4;

constexpr size_t OUT_RET = (size_t)T * D, OUT_GDN = OUT_RET + 4194304, OUT_SSD = OUT_GDN + 4194304;

struct Params {
  const float *x_prompt, *x_sample, *state_ret, *state_gdn, *state_ssd, *c, *c_ctx;
  const float *norm1_w, *norm2_w, *w_mod, *b_mod, *w_in, *w_out, *ret_log_decay, *ret_norm_w;
  const float *hy_conv_w, *hy_conv_b, *hy_freq, *hy_w1, *hy_b1, *hy_w2, *hy_b2, *hy_w3, *hy_bias, *hy_norm_w;
  const float *gdn_conv_w, *gdn_A_log, *gdn_dt_bias, *gdn_norm_w;
  const float *ssd_conv_w, *ssd_conv_b, *ssd_A_log, *ssd_dt_bias, *ssd_D, *ssd_norm_w;
  const float *mlp_w1, *mlp_w2, *final_norm_w;
  float* out; unsigned char* ws;
};

__device__ __forceinline__ float wave_sum(float v) {
#pragma unroll
  for (int o = 32; o >= 1; o >>= 1) v += __shfl_xor(v, o);
  return v;
}
__device__ __forceinline__ bf16_t f2bf(float f) { unsigned u = __float_as_uint(f); u += 0x7FFFu + ((u >> 16) & 1u); return (bf16_t)(u >> 16); }
__device__ __forceinline__ float bf2f(bf16_t b) { return __uint_as_float(((unsigned)b) << 16); }
__device__ __forceinline__ unsigned pk2(float lo, float hi) { return pg8::cvt_pk_bf16(lo, hi); }
__device__ __forceinline__ float silu_f(float x) { return x / (1.f + __expf(-x)); }
__device__ __forceinline__ float sigmoid_f(float x) { return 1.f / (1.f + __expf(-x)); }
__device__ __forceinline__ float softplus_f(float x) { return x > 20.f ? x : log1pf(expf(x)); }
__device__ __forceinline__ void ld8(const bf16_t* p, float (&o)[8]) {
  const u32x4 v = *(const u32x4*)p;
  o[0] = __uint_as_float(v.x << 16); o[1] = __uint_as_float(v.x & 0xffff0000u);
  o[2] = __uint_as_float(v.y << 16); o[3] = __uint_as_float(v.y & 0xffff0000u);
  o[4] = __uint_as_float(v.z << 16); o[5] = __uint_as_float(v.z & 0xffff0000u);
  o[6] = __uint_as_float(v.w << 16); o[7] = __uint_as_float(v.w & 0xffff0000u);
}
__device__ __forceinline__ void ldf8(const float* p, float (&o)[8]) {
  const f32x4 a = *(const f32x4*)p, b = *(const f32x4*)(p + 4);
  o[0] = a.x; o[1] = a.y; o[2] = a.z; o[3] = a.w; o[4] = b.x; o[5] = b.y; o[6] = b.z; o[7] = b.w;
}
__device__ __forceinline__ void st8bf(bf16_t* p, const float (&v)[8]) {
  u32x4 w; w.x = pk2(v[0], v[1]); w.y = pk2(v[2], v[3]); w.z = pk2(v[4], v[5]); w.w = pk2(v[6], v[7]);
  *(u32x4*)p = w;
}
__device__ __forceinline__ void conv8(const bf16_t* prow, int t, int L, const float* cw, const float* cb, float (&o)[8]) {
  float x[8], w[8];
  ld8(prow, x); ldf8(cw + 768, w);
  if (cb) { float b[8]; ldf8(cb, b);
#pragma unroll
    for (int e = 0; e < 8; ++e) o[e] = x[e] * w[e] + b[e];
  } else {
#pragma unroll
    for (int e = 0; e < 8; ++e) o[e] = x[e] * w[e];
  }
  if (t > 0) { ld8(prow - NP, x); ldf8(cw, w);
#pragma unroll
    for (int e = 0; e < 8; ++e) o[e] += x[e] * w[e]; }
  if (t < L - 1) { ld8(prow + NP, x); ldf8(cw + 1536, w);
#pragma unroll
    for (int e = 0; e < 8; ++e) o[e] += x[e] * w[e]; }
}
__device__ __forceinline__ f32x4 mma_tile(const bf16_t* A, int lda, const bf16_t* Bt, int ldb, int K, f32x4 acc, int lane) {
  const bf16_t* ap = A + (lane & 15) * lda + (lane >> 4) * 8;
  const bf16_t* bp = Bt + (lane & 15) * ldb + (lane >> 4) * 8;
  for (int k0 = 0; k0 < K; k0 += 32) {
    const bf16x8 a = *(const bf16x8*)(ap + k0), b = *(const bf16x8*)(bp + k0);
    acc = __builtin_amdgcn_mfma_f32_16x16x32_bf16(a, b, acc, 0, 0, 0);
  }
  return acc;
}
__device__ __forceinline__ int next_task(unsigned* ctr, int* slot) {
  __syncthreads();
  if (threadIdx.x == 0) *slot = (int)atomicAdd(ctr, 1u);
  __syncthreads();
  return *(volatile int*)slot;
}
__device__ __forceinline__ const float* xrow_ptr(const Params& p, int layer, int row) {
  if (layer == 0) return row < TP ? p.x_prompt + (size_t)row * D : p.x_sample + (size_t)(row - TP) * D;
  return (const float*)(p.ws + WS_X) + (size_t)row * D;
}
__device__ __forceinline__ int cond_row(int row) { return row < TP ? 0 : 1 + ((row - TP) >> 11); }

struct EpiP {
  static constexpr bool PERM = true, AFTER_DRAIN = false;
  bf16_t* O; float* gates;
  __device__ __forceinline__ void operator()(const f32x4 (&acc)[2][2][4][2], const pg8::Unit& u, int wr, int wc, int fr, int fq) const {
    const int row0 = u.pm * 256 + wr * 64 + fr, col0 = u.pn * 256 + wc * 32 + 8 * fq;
#pragma unroll
    for (int ai = 0; ai < 2; ++ai)
#pragma unroll
      for (int m = 0; m < 4; ++m) {
        const int row = row0 + ai * 128 + m * 16;
#pragma unroll
        for (int bj = 0; bj < 2; ++bj) {
          const int col = col0 + bj * 128;
          const f32x4 v0 = acc[ai][bj][m][0], v1 = acc[ai][bj][m][1];
          u32x4 w; w.x = pk2(v0[0], v0[1]); w.y = pk2(v0[2], v0[3]); w.z = pk2(v1[0], v1[1]); w.w = pk2(v1[2], v1[3]);
          *(u32x4*)(O + (size_t)row * NP + col) = w;
          if (col >= 2816 && col < 2832) { float* g = gates + (size_t)row * 32 + (col - 2816); *(f32x4*)g = v0; *(f32x4*)(g + 4) = v1; }
          if (col == 3856) { float* g = gates + (size_t)row * 32 + 16; *(f32x4*)g = v0; *(f32x4*)(g + 4) = v1; }
        }
      }
  }
};
struct EpiRelu2 {
  static constexpr bool PERM = true, AFTER_DRAIN = false;
  bf16_t* O;
  __device__ __forceinline__ void operator()(const f32x4 (&acc)[2][2][4][2], const pg8::Unit& u, int wr, int wc, int fr, int fq) const {
    const int row0 = u.pm * 256 + wr * 64 + fr, col0 = u.pn * 256 + wc * 32 + 8 * fq;
#pragma unroll
    for (int ai = 0; ai < 2; ++ai)
#pragma unroll
      for (int m = 0; m < 4; ++m) {
        const int row = row0 + ai * 128 + m * 16;
#pragma unroll
        for (int bj = 0; bj < 2; ++bj) {
          const int col = col0 + bj * 128;
          f32x4 v0 = acc[ai][bj][m][0], v1 = acc[ai][bj][m][1];
#pragma unroll
          for (int j = 0; j < 4; ++j) { const float a = fmaxf(v0[j], 0.f), b = fmaxf(v1[j], 0.f); v0[j] = a * a; v1[j] = b * b; }
          u32x4 w; w.x = pk2(v0[0], v0[1]); w.y = pk2(v0[2], v0[3]); w.z = pk2(v1[0], v1[1]); w.w = pk2(v1[2], v1[3]);
          *(u32x4*)(O + (size_t)row * NP + col) = w;
        }
      }
  }
};
struct EpiRes {
  static constexpr bool PERM = false, AFTER_DRAIN = false;
  const float* xin_p; const float* xin_s; float* xout; const float* gate;
  __device__ __forceinline__ void operator()(const f32x4 (&acc)[2][2][4][2], const pg8::Unit& u, int wr, int wc, int fr, int fq) const {
    const int row0 = u.pm * 256 + wr * 64 + fr, col0 = u.pn * 256 + wc * 32 + 4 * fq;
#pragma unroll
    for (int ai = 0; ai < 2; ++ai)
#pragma unroll
      for (int m = 0; m < 4; ++m) {
        const int row = row0 + ai * 128 + m * 16;
        const float* xi = row < TP ? xin_p + (size_t)row * D : xin_s + (size_t)(row - TP) * D;
        const float* gr = gate + (size_t)cond_row(row) * 6144;
        float* xo = xout + (size_t)row * D;
#pragma unroll
        for (int bj = 0; bj < 2; ++bj)
#pragma unroll
          for (int n = 0; n < 2; ++n) {
            const int col = col0 + bj * 128 + n * 16;
            const f32x4 xv = *(const f32x4*)(xi + col), gv = *(const f32x4*)(gr + col);
            *(f32x4*)(xo + col) = xv + gv * acc[ai][bj][m][n];
          }
      }
  }
};

__device__ __forceinline__ void phase0(const Params& p, unsigned char* lds) {
  int tid_l = threadIdx.x; asm volatile("" : "+v"(tid_l));
  const int tid = tid_l;
  float* mod = (float*)(p.ws + WS_MOD);
  float* taps = (float*)(p.ws + WS_TAPS);
  if (blockIdx.x == 0 && tid < 64) ((unsigned*)(p.ws + WS_CTR))[tid] = 0u;
  float* sF = (float*)lds;
  constexpr int NMOD = NL * 48, NTAP = NL * 288;
  for (int task = blockIdx.x; task < NMOD + NTAP; task += gridDim.x) {
    __syncthreads();
    if (task < NMOD) {
      const int l = task / 48, cb = task % 48;
      float* sC = sF;
      float* sR = sF + 5120;
      for (int i = tid; i < 5120; i += 512) { const int r = i >> 10, k = i & 1023; const float v = (r == 0) ? p.c_ctx[k] : p.c[(r - 1) * 1024 + k]; sC[i] = silu_f(v); }
      __syncthreads();
      const int col = cb * 128 + (tid & 127), kq = tid >> 7;
      float a0 = 0.f, a1 = 0.f, a2 = 0.f, a3 = 0.f, a4 = 0.f;
      const float* wp = p.w_mod + ((size_t)l * 1024 + kq * 256) * 6144 + col;
#pragma unroll 8
      for (int k = 0; k < 256; ++k) {
        const float w = wp[(size_t)k * 6144]; const int kk = kq * 256 + k;
        a0 += sC[kk] * w; a1 += sC[1024 + kk] * w; a2 += sC[2048 + kk] * w; a3 += sC[3072 + kk] * w; a4 += sC[4096 + kk] * w;
      }
      float* rr = sR + kq * 640 + (tid & 127);
      rr[0] = a0; rr[128] = a1; rr[256] = a2; rr[384] = a3; rr[512] = a4;
      __syncthreads();
      if (tid < 128) {
        const float b = p.b_mod[l * 6144 + col];
#pragma unroll
        for (int r = 0; r < 5; ++r) mod[((size_t)l * 5 + r) * 6144 + col] = sR[r * 128 + tid] + sR[640 + r * 128 + tid] + sR[1280 + r * 128 + tid] + sR[1920 + r * 128 + tid] + b;
      }
    } else {
      const int tt = task - NMOD, l = tt / 288, g = tt % 288;
      const int L = g < 32 ? 256 : 2048, i0 = g < 32 ? g * 8 : (g - 32) * 8;
      float* sZ = sF;
      float* sH1 = sF + 288;
      float* sH2 = sF + 288 + 512;
      const int r8 = tid >> 6, j = tid & 63, i = i0 + r8;
      const float tn = (float)i / (float)(L - 1);
      if (j < 33) {
        float z;
        if (j == 0) z = tn;
        else {
          const int b = (j - 1) & 15;
          const float f = 1e-4f + (float)b * ((15.0f - 1e-4f) / 15.0f);
          const float wang = 6.283185307179586f * (float)i / (float)L;
          z = (j <= 16) ? cosf(f * wang) : -sinf(f * wang);
        }
        sZ[r8 * 36 + j] = z;
      }
      __syncthreads();
      const float fr = p.hy_freq[l * 64 + j];
      { float a = p.hy_b1[l * 64 + j];
        for (int e = 0; e < 33; ++e) a += sZ[r8 * 36 + e] * p.hy_w1[(l * 33 + e) * 64 + j];
        sH1[r8 * 64 + j] = sinf(fr * a); }
      __syncthreads();
      { float a = p.hy_b2[l * 64 + j];
        for (int e = 0; e < 64; ++e) a += sH1[r8 * 64 + e] * p.hy_w2[(l * 64 + e) * 64 + j];
        sH2[r8 * 64 + j] = sinf(fr * a); }
      __syncthreads();
      float acc[8];
#pragma unroll
      for (int r = 0; r < 8; ++r) acc[r] = 0.f;
      for (int e = 0; e < 64; ++e) {
        const float w = p.hy_w3[(l * 64 + e) * 512 + tid];
#pragma unroll
        for (int r = 0; r < 8; ++r) acc[r] += sH2[r * 64 + e] * w;
      }
      const int dir = tid >> 8, c = tid & 255;
      const float delta = 3.0701134573253944f + (float)c * ((15.350567286626973f - 3.0701134573253944f) / 255.0f);
      float* Hl = taps + ((size_t)l * 4608 + (L == 256 ? 0 : 512)) * 256;
#pragma unroll
      for (int r = 0; r < 8; ++r) {
        const int ii = i0 + r; const float tnr = (float)ii / (float)(L - 1);
        const float v = acc[r] * expf(-tnr * delta);
        if (dir == 0) Hl[(size_t)(L - 1 + ii) * 256 + c] = v;
        else if (ii >= 1) Hl[(size_t)(L - 1 - ii) * 256 + c] = v;
        else Hl[(size_t)(2 * L - 1) * 256 + c] = 0.f;
      }
    }
  }
}

__device__ __forceinline__ void convert_tile(const float* W, int K, int N, bf16_t* WT, int tile, int ntn, float* sT) {
  int tid_l = threadIdx.x; asm volatile("" : "+v"(tid_l));
  const int tid = tid_l, kt = tile / ntn, nt = tile % ntn, k0 = kt * 64, n0 = nt * 64;
  __syncthreads();
#pragma unroll
  for (int i = 0; i < 8; ++i) {
    const int e = tid + i * 512, kk = e >> 6, nn = e & 63;
    sT[kk * 65 + nn] = (n0 + nn < N) ? W[(size_t)(k0 + kk) * N + n0 + nn] : 0.f;
  }
  __syncthreads();
  const int n = tid >> 3, kc = (tid & 7) * 8;
  float v[8];
#pragma unroll
  for (int e = 0; e < 8; ++e) v[e] = sT[(kc + e) * 65 + n];
  st8bf(WT + (size_t)(n0 + n) * K + k0 + kc, v);
}
__device__ __forceinline__ void convert_weights(const Params& p, int layer, unsigned char* lds) {
  float* sT = (float*)lds;
  constexpr int N_IN = 16 * 64, N_OUT = 16 * 16, N_1 = 16 * 64, N_2 = 64 * 16;
  for (int it = blockIdx.x; it < N_IN + N_OUT + N_1 + N_2; it += gridDim.x) {
    int r = it;
    if (r < N_IN) { convert_tile(p.w_in + (size_t)layer * 1024 * INC, 1024, INC, (bf16_t*)(p.ws + WS_WIN), r, 64, sT); continue; } r -= N_IN;
    if (r < N_OUT) { convert_tile(p.w_out + (size_t)layer * 1024 * 1024, 1024, 1024, (bf16_t*)(p.ws + WS_WOUT), r, 16, sT); continue; } r -= N_OUT;
    if (r < N_1) { convert_tile(p.mlp_w1 + (size_t)layer * 1024 * 4096, 1024, 4096, (bf16_t*)(p.ws + WS_W1), r, 64, sT); continue; } r -= N_1;
    convert_tile(p.mlp_w2 + (size_t)layer * 4096 * 1024, 4096, 1024, (bf16_t*)(p.ws + WS_W2), r, 16, sT);
  }
  __syncthreads();
}

__device__ __forceinline__ void norm_phase(const Params& p, int layer, int which  ) {
  int tid_l = threadIdx.x; asm volatile("" : "+v"(tid_l));
  const int lane = tid_l & 63, wv = tid_l >> 6;
  const float* nw = (which ? p.norm2_w : p.norm1_w) + layer * D;
  const float* mod = (const float*)(p.ws + WS_MOD) + (size_t)layer * 5 * 6144 + which * 3072;
  bf16_t* H = (bf16_t*)(p.ws + WS_H);
  for (int row = blockIdx.x * 8 + wv; row < T; row += gridDim.x * 8) {
    const float* xr = which ? (const float*)(p.ws + WS_X) + (size_t)row * D : xrow_ptr(p, layer, row);
    const float* mr = mod + (size_t)cond_row(row) * 6144;
    f32x4 v[4]; float ss = 0.f;
#pragma unroll
    for (int j = 0; j < 4; ++j) { v[j] = *(const f32x4*)(xr + j * 256 + lane * 4); ss += v[j].x * v[j].x + v[j].y * v[j].y + v[j].z * v[j].z + v[j].w * v[j].w; }
    const float rstd = rsqrtf(wave_sum(ss) * (1.f / D) + EPS);
#pragma unroll
    for (int j = 0; j < 4; ++j) {
      const int col = j * 256 + lane * 4;
      const f32x4 w = *(const f32x4*)(nw + col), sh = *(const f32x4*)(mr + col), sc = *(const f32x4*)(mr + 1024 + col);
      const f32x4 o = v[j] * rstd * w * (sc + 1.f) + sh;
      u32x2 pk; pk.x = pk2(o.x, o.y); pk.y = pk2(o.z, o.w);
      *(u32x2*)(H + (size_t)row * D + col) = pk;
    }
  }
}
__device__ __forceinline__ void final_norm(const Params& p) {
  int tid_l = threadIdx.x; asm volatile("" : "+v"(tid_l));
  const int lane = tid_l & 63, wv = tid_l >> 6;
  for (int row = blockIdx.x * 8 + wv; row < T; row += gridDim.x * 8) {
    const float* xr = (const float*)(p.ws + WS_X) + (size_t)row * D;
    f32x4 v[4]; float ss = 0.f;
#pragma unroll
    for (int j = 0; j < 4; ++j) { v[j] = *(const f32x4*)(xr + j * 256 + lane * 4); ss += v[j].x * v[j].x + v[j].y * v[j].y + v[j].z * v[j].z + v[j].w * v[j].w; }
    const float rstd = rsqrtf(wave_sum(ss) * (1.f / D) + EPS);
#pragma unroll
    for (int j = 0; j < 4; ++j) {
      const int col = j * 256 + lane * 4;
      const f32x4 w = *(const f32x4*)(p.final_norm_w + col);
      *(f32x4*)(p.out + (size_t)row * D + col) = v[j] * rstd * w;
    }
  }
}

template <bool SSD>
__device__ __forceinline__ void decay_task(const Params& p, int layer, int seq, int head, int dir, unsigned char* lds) {
  constexpr int KD = SSD ? 128 : 64, LQ = KD + 8, NST = KD / 32;
  bf16_t* sQ = (bf16_t*)(lds + 64); bf16_t* sQs = sQ + 64 * LQ; bf16_t* sK = sQs + 64 * LQ; bf16_t* sSt = sK + 64 * LQ;
  bf16_t* sKdt = sSt + 64 * LQ; bf16_t* sVt = sKdt + KD * 72; bf16_t* sAtt = sVt + 64 * 72; bf16_t* sXs = sAtt + 64 * 72;
  float* sCum = (float*)(sXs + 64 * 72); float* sDt = sCum + 64;
  const bf16_t* P = (const bf16_t*)(p.ws + WS_P);
  const float* gates = (const float*)(p.ws + WS_GATE);
  bf16_t* Odst = (bf16_t*)(p.ws + (dir ? WS_OB : WS_MIX));
  int tid_l = threadIdx.x; asm volatile("" : "+v"(tid_l));
  const int tid = tid_l, lane = tid & 63, w = tid >> 6, r = tid >> 3, sub = tid & 7;
  const bool sample = seq >= 32; const int L = sample ? 2048 : 256, seqbase = sample ? TP + (seq - 32) * 2048 : seq * 256, nch = L / 64;
  const int tr = w >> 1, tcs = (w & 1) * NST, tca = (w & 1) * 2;
  const int gidx = (layer * 2 + dir) * 4 + head;
  const int colbase = SSD ? 768 : 0;
  f32x4 accS[NST];
  if (sample) {
    const float* src = (SSD ? p.state_ssd : p.state_ret) + ((((size_t)(seq - 32) * 4 + layer) * 2 + dir) * 4 + head) * (KD * 64);
#pragma unroll
    for (int q = 0; q < NST; ++q) accS[q] = *(const f32x4*)(src + (16 * (tcs + q) + (lane & 15)) * 64 + 16 * tr + (lane >> 4) * 4);
  } else {
#pragma unroll
    for (int q = 0; q < NST; ++q) accS[q] = (f32x4){0.f, 0.f, 0.f, 0.f};
  }
  const float la_ret = SSD ? 0.f : p.ret_log_decay[gidx];
  const float Aneg = SSD ? -expf(p.ssd_A_log[gidx]) : 0.f, dtb = SSD ? p.ssd_dt_bias[gidx] : 0.f, Dh = SSD ? p.ssd_D[layer * 4 + head] : 0.f;
  const int grp = head >> 1;

  for (int n = 0; n < nch; ++n) {
    const int pos = n * 64 + r, t = dir ? L - 1 - pos : pos;
    const bf16_t* prow = P + (size_t)(seqbase + t) * NP;
    float qv[KD / 64][8], kv[KD / 64][8], vv[8], xs[8];
    if constexpr (!SSD) {
      ld8(prow + C_RQ + head * 64 + sub * 8, qv[0]); ld8(prow + C_RK + head * 64 + sub * 8, kv[0]); ld8(prow + C_RV + head * 64 + sub * 8, vv);
#pragma unroll
      for (int e = 0; e < 8; ++e) kv[0][e] *= 0.125f;
      if (sample) {
        const float rowpos = (float)(t >> 6), colpos = (float)(t & 63);
#pragma unroll
        for (int e = 0; e < 8; ++e) {
          const int i = (sub & 3) * 8 + e;
          const float inv = exp2f(-(float)(i & 15) * (13.287712379549449f / 16.0f));
          const float ang = (i < 16 ? rowpos : colpos) * inv;
          float sn, cs; sincosf(ang, &sn, &cs);
          const float oq = __shfl_xor(qv[0][e], 4), ok = __shfl_xor(kv[0][e], 4);
          if (sub < 4) { qv[0][e] = qv[0][e] * cs - oq * sn; kv[0][e] = kv[0][e] * cs - ok * sn; }
          else { qv[0][e] = oq * sn + qv[0][e] * cs; kv[0][e] = ok * sn + kv[0][e] * cs; }
        }
      }
    } else {
      const float* cw = p.ssd_conv_w + (size_t)layer * 3 * 768; const float* cb = p.ssd_conv_b + layer * 768;
      { const int ch = head * 64 + sub * 8; conv8(prow + C_SX + ch, t, L, cw + ch, cb + ch, xs);
#pragma unroll
        for (int e = 0; e < 8; ++e) xs[e] = silu_f(xs[e]); }
#pragma unroll
      for (int g = 0; g < 2; ++g) {
        const int chb = 256 + grp * 128 + g * 64 + sub * 8, chc = 512 + grp * 128 + g * 64 + sub * 8;
        conv8(prow + C_SX + chb, t, L, cw + chb, cb + chb, kv[g]); conv8(prow + C_SX + chc, t, L, cw + chc, cb + chc, qv[g]);
#pragma unroll
        for (int e = 0; e < 8; ++e) { kv[g][e] = silu_f(kv[g][e]); qv[g][e] = silu_f(qv[g][e]); }
      }
    }
    if (tid < 64) {
      float la, dtv = 0.f;
      if constexpr (SSD) {
        const int pos2 = n * 64 + tid, t2 = dir ? L - 1 - pos2 : pos2;
        dtv = softplus_f(gates[(size_t)(seqbase + t2) * 32 + 16 + dir * 4 + head] + dtb); la = Aneg * dtv;
      } else la = la_ret;
      float c = la;
#pragma unroll
      for (int o = 1; o < 64; o <<= 1) { const float y = __shfl_up(c, o); if (lane >= o) c += y; }
      sCum[tid] = c; sDt[tid] = dtv;
    }
    __syncthreads();
    const float cum_r = sCum[r], last = sCum[63];
    const float eq = __expf(cum_r), ek = __expf(last - cum_r);
    if constexpr (SSD) { const float dt_r = sDt[r];
#pragma unroll
      for (int e = 0; e < 8; ++e) vv[e] = xs[e] * dt_r;
      st8bf(sXs + r * 72 + sub * 8, xs); }
#pragma unroll
    for (int g = 0; g < KD / 64; ++g) {
      st8bf(sQ + r * LQ + g * 64 + sub * 8, qv[g]); st8bf(sK + r * LQ + g * 64 + sub * 8, kv[g]);
      float qs[8];
#pragma unroll
      for (int e = 0; e < 8; ++e) { qs[e] = qv[g][e] * eq; sKdt[(g * 64 + sub * 8 + e) * 72 + r] = f2bf(kv[g][e] * ek); }
      st8bf(sQs + r * LQ + g * 64 + sub * 8, qs);
    }
#pragma unroll
    for (int e = 0; e < 8; ++e) sVt[(sub * 8 + e) * 72 + r] = f2bf(vv[e]);
#pragma unroll
    for (int q = 0; q < NST; ++q)
#pragma unroll
      for (int j = 0; j < 4; ++j) sSt[(16 * tr + (lane >> 4) * 4 + j) * LQ + 16 * (tcs + q) + (lane & 15)] = f2bf(accS[q][j]);
    __syncthreads();
    f32x4 accO[2];
#pragma unroll
    for (int c2 = 0; c2 < 2; ++c2) {
      const int tc = tca + c2;
      f32x4 a = mma_tile(sQ + 16 * tr * LQ, LQ, sK + 16 * tc * LQ, LQ, KD, (f32x4){0.f, 0.f, 0.f, 0.f}, lane);
      accO[c2] = mma_tile(sQs + 16 * tr * LQ, LQ, sSt + 16 * tc * LQ, LQ, KD, (f32x4){0.f, 0.f, 0.f, 0.f}, lane);
      const int jj = 16 * tc + (lane & 15); const float cj = sCum[jj];
#pragma unroll
      for (int j = 0; j < 4; ++j) { const int i = 16 * tr + (lane >> 4) * 4 + j;
        const float val = (jj <= i) ? a[j] * __expf(sCum[i] - cj) : 0.f; sAtt[i * 72 + jj] = f2bf(val); }
    }
    __syncthreads();
#pragma unroll
    for (int c2 = 0; c2 < 2; ++c2) {
      const int tc = tca + c2;
      accO[c2] = mma_tile(sAtt + 16 * tr * 72, 72, sVt + 16 * tc * 72, 72, 64, accO[c2], lane);
      const int v = 16 * tc + (lane & 15);
#pragma unroll
      for (int j = 0; j < 4; ++j) { const int i = 16 * tr + (lane >> 4) * 4 + j;
        float o = accO[c2][j];
        if constexpr (SSD) { if (dir == 0) o += bf2f(sXs[i * 72 + v]) * Dh; }
        const int pi = n * 64 + i, ti = dir ? L - 1 - pi : pi;
        Odst[(size_t)(seqbase + ti) * D + colbase + head * 64 + v] = f2bf(o); }
    }
    const float el = __expf(last);
#pragma unroll
    for (int q = 0; q < NST; ++q) { accS[q] = accS[q] * el; accS[q] = mma_tile(sVt + 16 * tr * 72, 72, sKdt + 16 * (tcs + q) * 72, 72, 64, accS[q], lane); }
    __syncthreads();
  }
  if (!sample) {
    float* dst = p.out + (SSD ? OUT_SSD : OUT_RET) + ((((size_t)seq * 4 + layer) * 2 + dir) * 4 + head) * (KD * 64);
#pragma unroll
    for (int q = 0; q < NST; ++q) *(f32x4*)(dst + (16 * (tcs + q) + (lane & 15)) * 64 + 16 * tr + (lane >> 4) * 4) = accS[q];
  }
}

__device__ __forceinline__ void gdn_task(const Params& p, int layer, int seq, int head, int dir, unsigned char* lds) {
  constexpr int LQ = 72;
  bf16_t* sQ = (bf16_t*)(lds + 64); bf16_t* sQs = sQ + 64 * LQ; bf16_t* sK = sQs + 64 * LQ; bf16_t* sSt = sK + 64 * LQ;
  bf16_t* sKdt = sSt + 64 * LQ; bf16_t* sAtt = sKdt + 64 * LQ; bf16_t* sVNt = sAtt + 64 * LQ; bf16_t* sW = sVNt + 64 * LQ;
  float* sA = (float*)(sW + 64 * LQ);
  float* sR = sA + 64 * 68;
  float* sCum = sR + 64 * 132; float* sBeta = sCum + 64;
  const bf16_t* P = (const bf16_t*)(p.ws + WS_P);
  const float* gates = (const float*)(p.ws + WS_GATE);
  bf16_t* Odst = (bf16_t*)(p.ws + (dir ? WS_OB : WS_MIX));
  int tid_l = threadIdx.x; asm volatile("" : "+v"(tid_l));
  const int tid = tid_l, lane = tid & 63, w = tid >> 6, r = tid >> 3, sub = tid & 7;
  const bool sample = seq >= 32; const int L = sample ? 2048 : 256, seqbase = sample ? TP + (seq - 32) * 2048 : seq * 256, nch = L / 64;
  const int tr = w >> 1, tca = (w & 1) * 2;
  const int gidx = (layer * 2 + dir) * 4 + head;
  f32x4 accS[2];
  if (sample) {
    const float* src = p.state_gdn + ((((size_t)(seq - 32) * 4 + layer) * 2 + dir) * 4 + head) * 4096;
#pragma unroll
    for (int q = 0; q < 2; ++q) accS[q] = *(const f32x4*)(src + (16 * (tca + q) + (lane & 15)) * 64 + 16 * tr + (lane >> 4) * 4);
  } else {
#pragma unroll
    for (int q = 0; q < 2; ++q) accS[q] = (f32x4){0.f, 0.f, 0.f, 0.f};
  }
  const float Aneg = -expf(p.gdn_A_log[gidx]), dtb = p.gdn_dt_bias[gidx];
  const float* cw = p.gdn_conv_w + (size_t)layer * 3 * 768;

  for (int n = 0; n < nch; ++n) {
    const int pos = n * 64 + r, t = dir ? L - 1 - pos : pos;
    const bf16_t* prow = P + (size_t)(seqbase + t) * NP;
    float qv[8], kv[8], vv[8];
    const int ch = head * 64 + sub * 8;
    conv8(prow + C_GQ + ch, t, L, cw + ch, nullptr, qv); conv8(prow + C_GK + ch, t, L, cw + 256 + ch, nullptr, kv); conv8(prow + C_GV + ch, t, L, cw + 512 + ch, nullptr, vv);
    float sq = 0.f, sk = 0.f;
#pragma unroll
    for (int e = 0; e < 8; ++e) { qv[e] = silu_f(qv[e]); kv[e] = silu_f(kv[e]); vv[e] = silu_f(vv[e]); sq += qv[e] * qv[e]; sk += kv[e] * kv[e]; }
    sq += __shfl_xor(sq, 1); sq += __shfl_xor(sq, 2); sq += __shfl_xor(sq, 4);
    sk += __shfl_xor(sk, 1); sk += __shfl_xor(sk, 2); sk += __shfl_xor(sk, 4);
    const float rq = rsqrtf(sq + EPS) * 0.125f, rk = rsqrtf(sk + EPS);
#pragma unroll
    for (int e = 0; e < 8; ++e) { qv[e] *= rq; kv[e] *= rk; }
    if (tid < 64) {
      const int pos2 = n * 64 + tid, t2 = dir ? L - 1 - pos2 : pos2;
      const float* gr = gates + (size_t)(seqbase + t2) * 32;
      const float la = Aneg * softplus_f(gr[dir * 4 + head] + dtb);
      float c = la;
#pragma unroll
      for (int o = 1; o < 64; o <<= 1) { const float y = __shfl_up(c, o); if (lane >= o) c += y; }
      sCum[tid] = c; sBeta[tid] = sigmoid_f(gr[8 + dir * 4 + head]);
    }
    __syncthreads();
    const float cum_r = sCum[r], last = sCum[63], beta_r = sBeta[r];
    const float eq = __expf(cum_r), ek = __expf(last - cum_r);
    st8bf(sQ + r * LQ + sub * 8, qv); st8bf(sK + r * LQ + sub * 8, kv);
    { float qs[8];
#pragma unroll
      for (int e = 0; e < 8; ++e) { qs[e] = qv[e] * eq; sKdt[(sub * 8 + e) * LQ + r] = f2bf(kv[e] * ek);
        sR[r * 132 + sub * 8 + e] = kv[e] * (beta_r * eq); sR[r * 132 + 64 + sub * 8 + e] = vv[e] * beta_r; }
      st8bf(sQs + r * LQ + sub * 8, qs); }
#pragma unroll
    for (int q = 0; q < 2; ++q)
#pragma unroll
      for (int j = 0; j < 4; ++j) sSt[(16 * tr + (lane >> 4) * 4 + j) * LQ + 16 * (tca + q) + (lane & 15)] = f2bf(accS[q][j]);
    __syncthreads();
    f32x4 accO[2];
#pragma unroll
    for (int c2 = 0; c2 < 2; ++c2) {
      const int tc = tca + c2;
      const f32x4 kk = mma_tile(sK + 16 * tr * LQ, LQ, sK + 16 * tc * LQ, LQ, 64, (f32x4){0.f, 0.f, 0.f, 0.f}, lane);
      const f32x4 qk = mma_tile(sQ + 16 * tr * LQ, LQ, sK + 16 * tc * LQ, LQ, 64, (f32x4){0.f, 0.f, 0.f, 0.f}, lane);
      accO[c2] = mma_tile(sQs + 16 * tr * LQ, LQ, sSt + 16 * tc * LQ, LQ, 64, (f32x4){0.f, 0.f, 0.f, 0.f}, lane);
      const int jj = 16 * tc + (lane & 15); const float cj = sCum[jj];
#pragma unroll
      for (int j = 0; j < 4; ++j) { const int i = 16 * tr + (lane >> 4) * 4 + j;
        const float dec = (jj <= i) ? __expf(sCum[i] - cj) : 0.f;
        sA[i * 68 + jj] = (jj < i) ? kk[j] * dec * sBeta[i] : 0.f;
        sAtt[i * LQ + jj] = f2bf(qk[j] * dec); }
    }
    __syncthreads();
    if (tid < 128) {
      float x[64];
      int vz = 0; asm volatile("" : "+v"(vz));
      const float* sAz = sA + vz;
#pragma unroll
      for (int i = 0; i < 64; ++i) {
        float s = sR[i * 132 + tid];
#pragma unroll
        for (int j = 0; j < i; ++j) s -= sAz[i * 68 + j] * x[j];
        x[i] = s;
      }
      if (tid < 64) {
#pragma unroll
        for (int i = 0; i < 64; ++i) sW[i * LQ + tid] = f2bf(x[i]);
      } else {
#pragma unroll
        for (int i = 0; i < 64; ++i) sR[i * 132 + tid] = x[i];
      }
    }
    __syncthreads();
#pragma unroll
    for (int c2 = 0; c2 < 2; ++c2) {
      const int tc = tca + c2;
      const f32x4 ws = mma_tile(sW + 16 * tr * LQ, LQ, sSt + 16 * tc * LQ, LQ, 64, (f32x4){0.f, 0.f, 0.f, 0.f}, lane);
      const int v = 16 * tc + (lane & 15);
#pragma unroll
      for (int j = 0; j < 4; ++j) { const int cI = 16 * tr + (lane >> 4) * 4 + j; sVNt[v * LQ + cI] = f2bf(sR[cI * 132 + 64 + v] - ws[j]); }
    }
    __syncthreads();
#pragma unroll
    for (int c2 = 0; c2 < 2; ++c2) {
      const int tc = tca + c2;
      accO[c2] = mma_tile(sAtt + 16 * tr * LQ, LQ, sVNt + 16 * tc * LQ, LQ, 64, accO[c2], lane);
      const int v = 16 * tc + (lane & 15);
#pragma unroll
      for (int j = 0; j < 4; ++j) { const int i = 16 * tr + (lane >> 4) * 4 + j;
        const int pi = n * 64 + i, ti = dir ? L - 1 - pi : pi;
        Odst[(size_t)(seqbase + ti) * D + 512 + head * 64 + v] = f2bf(accO[c2][j]); }
    }
    const float el = __expf(last);
#pragma unroll
    for (int q = 0; q < 2; ++q) { accS[q] = accS[q] * el; accS[q] = mma_tile(sVNt + 16 * tr * LQ, LQ, sKdt + 16 * (tca + q) * LQ, LQ, 64, accS[q], lane); }
    __syncthreads();
  }
  if (!sample) {
    float* dst = p.out + OUT_GDN + ((((size_t)seq * 4 + layer) * 2 + dir) * 4 + head) * 4096;
#pragma unroll
    for (int q = 0; q < 2; ++q) *(f32x4*)(dst + (16 * (tca + q) + (lane & 15)) * 64 + 16 * tr + (lane >> 4) * 4) = accS[q];
  }
}

__device__ __forceinline__ void hy1_task(const Params& p, int layer, int g) {
  const bf16_t* P = (const bf16_t*)(p.ws + WS_P);
  float* U = (float*)(p.ws + WS_U); float* X0 = (float*)(p.ws + WS_X0);
  int tid_l = threadIdx.x; asm volatile("" : "+v"(tid_l));
  const int tid = tid_l, r = tid >> 3, sub = tid & 7;
  const int row = g * 64 + r;
  const bool sample = row >= TP; const int L = sample ? 2048 : 256, t = sample ? (row - TP) & 2047 : row & 255;
  const bf16_t* prow = P + (size_t)row * NP + C_HY;
  const float* cw = p.hy_conv_w + (size_t)layer * 3 * 768; const float* cb = p.hy_conv_b + layer * 768;
#pragma unroll
  for (int q = 0; q < 4; ++q) {
    const int ch = q * 64 + sub * 8;
    float x0[8], x1[8], v[8];
    conv8(prow + ch, t, L, cw + ch, cb + ch, x0); conv8(prow + 256 + ch, t, L, cw + 256 + ch, cb + 256 + ch, x1); conv8(prow + 512 + ch, t, L, cw + 512 + ch, cb + 512 + ch, v);
    float* up = U + (size_t)row * 256 + ch; float* xp = X0 + (size_t)row * 256 + ch;
    *(f32x4*)up = (f32x4){v[0] * x1[0], v[1] * x1[1], v[2] * x1[2], v[3] * x1[3]};
    *(f32x4*)(up + 4) = (f32x4){v[4] * x1[4], v[5] * x1[5], v[6] * x1[6], v[7] * x1[7]};
    *(f32x4*)xp = (f32x4){x0[0], x0[1], x0[2], x0[3]};
    *(f32x4*)(xp + 4) = (f32x4){x0[4], x0[5], x0[6], x0[7]};
  }
}

__device__ __forceinline__ void hy2_task(const Params& p, int layer, int row0, unsigned char* lds) {
  const float* U = (const float*)(p.ws + WS_U); const float* X0 = (const float*)(p.ws + WS_X0);
  bf16_t* MIX = (bf16_t*)(p.ws + WS_MIX);
  float* sRed = (float*)(lds + 64);
  int tid_l = threadIdx.x; asm volatile("" : "+v"(tid_l));
  const int tid = tid_l, c = tid & 255, half = tid >> 8, lane = tid & 63, wq = (tid >> 6) & 3;
  const bool sample = row0 >= TP; const int L = sample ? 2048 : 256;
  const int seqbase = sample ? TP + (((row0 - TP) >> 11) << 11) : (row0 >> 8) << 8;
  const int tl0 = row0 + half * 16 - seqbase;
  const float* Hl = (const float*)(p.ws + WS_TAPS) + ((size_t)layer * 4608 + (sample ? 512 : 0)) * 256 + c;
  const float* Us = U + (size_t)seqbase * 256 + c;
  float acc[16];
#pragma unroll
  for (int r = 0; r < 16; ++r) acc[r] = 0.f;
  for (int sb = 0; sb < L; sb += 16) {
    const int dd0 = tl0 - sb - 15 + L - 1;
    float hw[31], uu[16];
#pragma unroll
    for (int m = 0; m < 31; ++m) hw[m] = Hl[(size_t)(dd0 + m) * 256];
#pragma unroll
    for (int q = 0; q < 16; ++q) uu[q] = Us[(size_t)(sb + q) * 256];
#pragma unroll
    for (int r = 0; r < 16; ++r)
#pragma unroll
      for (int q = 0; q < 16; ++q) acc[r] += hw[15 + r - q] * uu[q];
  }
  const float hb = p.hy_bias[layer * 256 + c], nw = p.hy_norm_w[layer * 256 + c];
#pragma unroll
  for (int r = 0; r < 16; ++r) {
    const size_t row = (size_t)(seqbase + tl0 + r);
    const float u = U[row * 256 + c], x0 = X0[row * 256 + c];
    acc[r] = x0 * (acc[r] + u * hb);
    const float ss = wave_sum(acc[r] * acc[r]);
    if (lane == 0) sRed[(half * 16 + r) * 4 + wq] = ss;
  }
  __syncthreads();
#pragma unroll
  for (int r = 0; r < 16; ++r) {
    const float* s4 = sRed + (half * 16 + r) * 4;
    const float rstd = rsqrtf((s4[0] + s4[1] + s4[2] + s4[3]) * (1.f / 256.f) + EPS);
    MIX[(size_t)(seqbase + tl0 + r) * D + 256 + c] = f2bf(acc[r] * rstd * nw);
  }
}

__device__ __forceinline__ void finalize_rows(const Params& p, int layer) {
  const bf16_t* P = (const bf16_t*)(p.ws + WS_P);
  bf16_t* MIX = (bf16_t*)(p.ws + WS_MIX); const bf16_t* OB = (const bf16_t*)(p.ws + WS_OB);
  int tid_l = threadIdx.x; asm volatile("" : "+v"(tid_l));
  const int lane = tid_l & 63, wv = tid_l >> 6;
  for (int row = blockIdx.x * 8 + wv; row < T; row += gridDim.x * 8) {
    bf16_t* mr = MIX + (size_t)row * D; const bf16_t* br = OB + (size_t)row * D; const bf16_t* pr = P + (size_t)row * NP;
#pragma unroll
    for (int h = 0; h < 4; ++h) {
      { const int col = h * 64 + lane;
        const float o = bf2f(mr[col]) + bf2f(br[col]);
        const float rstd = rsqrtf(wave_sum(o * o) * (1.f / 64.f) + EPS);
        mr[col] = f2bf(o * rstd * p.ret_norm_w[layer * 256 + col] * silu_f(bf2f(pr[C_RG + col]))); }
      { const int col = h * 64 + lane;
        const float o = bf2f(mr[512 + col]) + bf2f(br[512 + col]);
        const float rstd = rsqrtf(wave_sum(o * o) * (1.f / 64.f) + EPS);
        mr[512 + col] = f2bf(o * rstd * p.gdn_norm_w[layer * 256 + col] * silu_f(bf2f(pr[C_GZ + col]))); }
    }
#pragma unroll
    for (int g = 0; g < 2; ++g) {
      const int c0 = g * 128 + lane, c1 = c0 + 64;
      const float y0 = (bf2f(mr[768 + c0]) + bf2f(br[768 + c0])) * silu_f(bf2f(pr[C_SZ + c0]));
      const float y1 = (bf2f(mr[768 + c1]) + bf2f(br[768 + c1])) * silu_f(bf2f(pr[C_SZ + c1]));
      const float rstd = rsqrtf(wave_sum(y0 * y0 + y1 * y1) * (1.f / 128.f) + EPS);
      mr[768 + c0] = f2bf(y0 * rstd * p.ssd_norm_w[layer * 256 + c0]);
      mr[768 + c1] = f2bf(y1 * rstd * p.ssd_norm_w[layer * 256 + c1]);
    }
  }
}

__global__ void __launch_bounds__(512) fwd_mega(Params p) {
  cg::grid_group grid = cg::this_grid();
  extern __shared__ __attribute__((aligned(16))) unsigned char lds[];
  PG8_LAS unsigned char* ldsl = (PG8_LAS unsigned char*)lds;
  int* slot = (int*)lds;
  unsigned* ctr = (unsigned*)(p.ws + WS_CTR);
  const bf16_t* Hb = (const bf16_t*)(p.ws + WS_H);
  bf16_t* Pb = (bf16_t*)(p.ws + WS_P);
  float* Xb = (float*)(p.ws + WS_X);
  const float* mod = (const float*)(p.ws + WS_MOD);

#ifndef X_NO_P0
  phase0(p, lds + 64);
#endif
  grid.sync();
  for (int layer = 0; layer < NL; ++layer) {
    convert_weights(p, layer, lds + 64);
    norm_phase(p, layer, 0);
    grid.sync();
    { pg8::Gemm g{Hb, (const bf16_t*)(p.ws + WS_WIN), T, NP, D}; pg8::StaticOrder S; S.init(T, NP, gridDim.x, blockIdx.x);
      EpiP E{Pb, (float*)(p.ws + WS_GATE)}; pg8::gemm_phase<EpiP, pg8::StaticOrder>(ldsl, g, S, E, nullptr); }
    grid.sync();
    for (;;) {
      const int id = next_task(ctr + layer * 4 + 0, slot);
      if (id >= 1120) break;
      if (id < 864) {
        int mixer, rem, seq;
        if (id < 96) { mixer = id >> 5; rem = id & 31; seq = 32 + (rem >> 3); }
        else { const int i2 = id - 96; mixer = i2 >> 8; rem = i2 & 255; seq = rem >> 3; }
        const int head = (rem >> 1) & 3, dir = rem & 1;
#ifndef X_NO_GDN
        if (mixer == 0) gdn_task(p, layer, seq, head, dir, lds);
#endif
#ifndef X_NO_SSD
        if (mixer == 1) decay_task<true>(p, layer, seq, head, dir, lds);
#endif
#ifndef X_NO_RET
        if (mixer == 2) decay_task<false>(p, layer, seq, head, dir, lds);
#endif
      } else {
#ifndef X_NO_HY1
        hy1_task(p, layer, id - 864);
#endif
      }
    }
    grid.sync();
    for (;;) {
      const int id = next_task(ctr + layer * 4 + 1, slot);
      if (id >= 512) break;
#ifndef X_NO_HY2
      hy2_task(p, layer, id < 256 ? TP + id * 32 : (id - 256) * 32, lds);
#endif
    }
    finalize_rows(p, layer);
    grid.sync();
    { pg8::Gemm g{(const bf16_t*)(p.ws + WS_MIX), (const bf16_t*)(p.ws + WS_WOUT), T, D, D}; pg8::StaticOrder S; S.init(T, D, gridDim.x, blockIdx.x);
      EpiRes E{layer == 0 ? p.x_prompt : Xb, layer == 0 ? p.x_sample : Xb + (size_t)TP * D, Xb, mod + (size_t)layer * 5 * 6144 + 2048};
      pg8::gemm_phase<EpiRes, pg8::StaticOrder>(ldsl, g, S, E, nullptr); }
    grid.sync();
    norm_phase(p, layer, 1);
    grid.sync();
    { pg8::Gemm g{Hb, (const bf16_t*)(p.ws + WS_W1), T, 4096, D}; pg8::StaticOrder S; S.init(T, 4096, gridDim.x, blockIdx.x);
      EpiRelu2 E{Pb}; pg8::gemm_phase<EpiRelu2, pg8::StaticOrder>(ldsl, g, S, E, nullptr); }
    grid.sync();
    { pg8::Gemm g{Pb, (const bf16_t*)(p.ws + WS_W2), T, D, 4096}; pg8::StaticOrder S; S.init(T, D, gridDim.x, blockIdx.x);
      EpiRes E{Xb, Xb + (size_t)TP * D, Xb, mod + (size_t)layer * 5 * 6144 + 5120};
      pg8::gemm_phase<EpiRes, pg8::StaticOrder>(ldsl, g, S, E, nullptr); }
    grid.sync();
  }
  final_norm(p);
}

extern "C" void kernel_launch(void* const* d_in, const int* in_sizes, int n_in, void* d_out, int out_size,
                              void* d_ws, size_t ws_size, hipStream_t stream) {
  constexpr size_t kDynLds = 144 * 1024;
  static int grid_blocks = 0;
  if (!grid_blocks) {
    int dev = 0, cus = 0, per_cu = 0;
    (void)hipGetDevice(&dev);
    (void)hipDeviceGetAttribute(&cus, hipDeviceAttributeMultiprocessorCount, dev);
    (void)hipFuncSetAttribute((const void*)fwd_mega, hipFuncAttributeMaxDynamicSharedMemorySize, (int)kDynLds);
    (void)hipOccupancyMaxActiveBlocksPerMultiprocessor(&per_cu, (const void*)fwd_mega, 512, kDynLds);
    grid_blocks = cus > 0 ? cus : 256;
    if (n_in != 38 || ws_size < WS_END || out_size != 33554432) { fprintf(stderr, "kernel_launch: unexpected sizes n_in %d ws %zu out %d\n", n_in, ws_size, out_size); grid_blocks = -1; }
  }
  if (grid_blocks < 0) return;
  Params p{};
  const float** pp = (const float**)&p;
  for (int i = 0; i < 38; ++i) pp[i] = (const float*)d_in[i];
  p.out = (float*)d_out; p.ws = (unsigned char*)d_ws;
  void* args[] = {&p};
  hipError_t e = hipLaunchCooperativeKernel((const void*)fwd_mega, dim3(grid_blocks), dim3(512), args, kDynLds, stream);
  if (e != hipSuccess) fprintf(stderr, "cooperative launch failed: %s (grid %d)\n", hipGetErrorString(e), grid_blocks);
}
```

```cpp
#include <hip/hip_runtime.h>
#include <hip/hip_cooperative_groups.h>
#include <cstdio>
namespace cg = cooperative_groups;
namespace pg8 {
#define PG8_LAS __attribute__((address_space(3)))
typedef unsigned short bf16_t;
typedef short bf16x8 __attribute__((ext_vector_type(8)));
typedef float f32x4 __attribute__((ext_vector_type(4)));
typedef unsigned u32x4 __attribute__((ext_vector_type(4)));
constexpr int BM = 256, BK = 64, HALF = 128, HTB = HALF * BK * 2  , STAGE_BYTES = 8 * HTB, NXCD = 8, WGM = 8;

__host__ __device__ __forceinline__ int lds_byte(int r, int c) { const int st = (r >> 4) * 2 + (c >> 5), rr = r & 15, cc = c & 31, ob = rr * 64 + cc * 2; return st * 1024 + (ob ^ (((ob >> 9) & 1) << 5)); }
__host__ __device__ __forceinline__ void stage_rc(int b, int& R, int& C) { const int st = b / 1024, sb = b % 1024, swz = sb ^ (((sb >> 9) & 1) << 5); R = (st >> 1) * 16 + swz / 64; C = (st & 1) * 32 + (swz % 64) / 2; }
__host__ __device__ __forceinline__ int perm32(int rho) { const int n = rho >> 4, i = rho & 15; return 8 * (i >> 2) + 4 * n + (i & 3); }

struct Unit { int pm, pn; };
struct Gemm { const bf16_t* A; const bf16_t* Bt; int M, N, K; };

struct StaticOrder {
    int nM, nN, nwg, G, c;
    __host__ __device__ void init(int M, int N, int G_, int c_) { nM = M / BM; nN = N / BM; nwg = nM * nN; G = G_; c = c_; }
    __host__ __device__ bool next(int i, Unit& u) const {
        const long L = (long)i * G + c; if (L >= nwg) return false;
        int wgid = (int)L; { const int q = nwg / NXCD, r = nwg % NXCD, xcd = wgid % NXCD, off = wgid / NXCD; wgid = (xcd < r ? xcd * (q + 1) : r * (q + 1) + (xcd - r) * q) + off; }
        const int nig = WGM * nN, gid = wgid / nig, fm = gid * WGM, gsz = (nM - fm) < WGM ? (nM - fm) : WGM;
        u.pm = fm + ((wgid % nig) % gsz); u.pn = (wgid % nig) / gsz; return true;
    }
    __device__ __forceinline__ void a_ready(const Unit&) const {}
    __device__ __forceinline__ void done(const Unit&) const {}
};
__device__ __forceinline__ unsigned cvt_pk_bf16(float lo, float hi) { unsigned r; asm volatile("v_cvt_pk_bf16_f32 %0, %1, %2" : "=v"(r) : "v"(lo), "v"(hi)); return r; }

template <class Epi, class Sched, bool STAMP = false>
__device__ __forceinline__ void gemm_phase(PG8_LAS unsigned char* lds, const Gemm g, const Sched& S, const Epi& E, unsigned long long* stamps) {
    int tid_l = threadIdx.x; asm volatile("" : "+v"(tid_l));
    const int tid = tid_l, wid = __builtin_amdgcn_readfirstlane(tid >> 6), lane = tid & 63, wr = wid >> 2, wc = wid & 3, fr = lane & 15, fq = lane >> 4;
    const int K = g.K, nt = K / BK;
    int ts_lo = 0, ts_hi = 0, nts = 0; const unsigned long long rt_entry = STAMP ? (unsigned long long)wall_clock64() : 0ull;
#define PG8_STAMP() do { if (STAMP && wid == 0 && nts < 64) { const unsigned long long _c = (unsigned long long)clock64(); \
        ts_lo = (lane == nts) ? (int)(unsigned)_c : ts_lo; ts_hi = (lane == nts) ? (int)(unsigned)(_c >> 32) : ts_hi; ++nts; } } while (0)
    PG8_STAMP();
    unsigned voffA[2], voffB[2];
#pragma unroll
    for (int i = 0; i < 2; ++i) { int R, C; stage_rc(tid * 16 + i * 8192, R, C); const int Rb = Epi::PERM ? ((R & ~31) + perm32(R & 31)) : R;
        voffA[i] = (unsigned)(R * K + C) * 2u; voffB[i] = (unsigned)(Rb * K + C) * 2u; }
    const size_t kstep = (size_t)(BK * 2);
    const size_t hstep = (size_t)HALF * K * 2;
    const size_t tstep = 2 * hstep;
    const unsigned ldsw = (unsigned)wid * 1024u;
    const int aoff = lds_byte(wr * 64 + fr, fq * 8), boff = lds_byte(wc * 32 + fr, fq * 8);
#define PG8_SA(b, h) (((b) * 2 + (h)) * HTB)
#define PG8_SB(b, h) ((4 + (b) * 2 + (h)) * HTB)
#define PG8_STAGE(bufoff, gbase, voff) do { _Pragma("unroll") for (int _i = 0; _i < 2; ++_i) \
        __builtin_amdgcn_global_load_lds((const unsigned*)((const char*)(gbase) + (voff)[_i]), (PG8_LAS unsigned*)(lds + (bufoff) + ldsw + _i * 8192), 16, 0, 0); } while (0)
#define PG8_LDA(dst, b, h) do { _Pragma("unroll") for (int m = 0; m < 4; ++m) _Pragma("unroll") for (int k = 0; k < 2; ++k) dst[m][k] = *(const PG8_LAS bf16x8*)(lds + PG8_SA(b, h) + aoff + m * 2048 + k * 1024); } while (0)
#define PG8_LDB(dst, b, h) do { _Pragma("unroll") for (int n = 0; n < 2; ++n) _Pragma("unroll") for (int k = 0; k < 2; ++k) dst[n][k] = *(const PG8_LAS bf16x8*)(lds + PG8_SB(b, h) + boff + n * 2048 + k * 1024); } while (0)
#define PG8_MMA(ai, bj, At, Bt) do { __builtin_amdgcn_s_setprio(1); _Pragma("unroll") for (int m = 0; m < 4; ++m) _Pragma("unroll") for (int n = 0; n < 2; ++n) _Pragma("unroll") for (int k = 0; k < 2; ++k) \
        acc[ai][bj][m][n] = __builtin_amdgcn_mfma_f32_16x16x32_bf16(Bt[n][k], At[m][k], acc[ai][bj][m][n], 0, 0, 0); __builtin_amdgcn_s_setprio(0); } while (0)
#define PG8_WAIT_V(n) asm volatile("s_waitcnt vmcnt(" #n ")" ::: "memory")
#define PG8_WAIT_L(n) asm volatile("s_waitcnt lgkmcnt(" #n ")" ::: "memory")
#define PG8_BAR __builtin_amdgcn_s_barrier()
#define PG8_SCHED __builtin_amdgcn_sched_barrier(0)
    Unit cur, nxt; int ui = 0;
    if (!S.next(0, cur)) return;
    f32x4 acc[2][2][4][2];
#pragma unroll
    for (int a = 0; a < 2; ++a)
#pragma unroll
        for (int b = 0; b < 2; ++b)
#pragma unroll
            for (int m = 0; m < 4; ++m)
#pragma unroll
                for (int n = 0; n < 2; ++n) acc[a][b][m][n] = (f32x4){0.f, 0.f, 0.f, 0.f};
    bf16x8 At[4][2], B0[2][2], B1[2][2];
    const char* cA = (const char*)g.A + (size_t)cur.pm * tstep; const char* cB = (const char*)g.Bt + (size_t)cur.pn * tstep;
    S.a_ready(cur);
    PG8_STAGE(PG8_SB(0, 0), cB, voffB); PG8_STAGE(PG8_SA(0, 0), cA, voffA); PG8_STAGE(PG8_SB(0, 1), cB + hstep, voffB); PG8_STAGE(PG8_SA(0, 1), cA + hstep, voffA);
    if (wr == 1) PG8_BAR;
    PG8_WAIT_V(4); PG8_BAR;
    PG8_STAGE(PG8_SB(1, 0), cB + kstep, voffB); PG8_STAGE(PG8_SA(1, 0), cA + kstep, voffA); PG8_STAGE(PG8_SB(1, 1), cB + hstep + kstep, voffB);
    PG8_WAIT_V(6); PG8_BAR;
    PG8_STAMP();
    for (;;) {
        const bool has_next = S.next(ui + 1, nxt);
        const char* nA = has_next ? (const char*)g.A + (size_t)nxt.pm * tstep : cA; const char* nB = has_next ? (const char*)g.Bt + (size_t)nxt.pn * tstep : cB;
        for (int t = 0; t < nt; t += 2) {
            const bool last = (t == nt - 2);
            const char* a1 = cA + (size_t)(t + 1) * kstep;
            const char* a2 = last ? nA : cA + (size_t)(t + 2) * kstep; const char* b2 = last ? nB : cB + (size_t)(t + 2) * kstep;
            const char* a3 = a2 + kstep; const char* b3 = b2 + kstep;
            if (last && has_next) S.a_ready(nxt);
            PG8_LDB(B0, 0, 0); PG8_SCHED; PG8_LDA(At, 0, 0); PG8_STAGE(PG8_SA(1, 1), a1 + hstep, voffA);
            PG8_WAIT_L(8); PG8_BAR; PG8_WAIT_L(0); PG8_MMA(0, 0, At, B0); PG8_BAR; PG8_SCHED;
            PG8_LDB(B1, 0, 1); PG8_STAGE(PG8_SB(0, 0), b2, voffB);
            PG8_BAR; PG8_WAIT_L(0); PG8_MMA(0, 1, At, B1); PG8_BAR;
            PG8_LDA(At, 0, 1); PG8_STAGE(PG8_SA(0, 0), a2, voffA);
            PG8_BAR; PG8_WAIT_L(0); PG8_MMA(1, 0, At, B0); PG8_BAR; PG8_SCHED;
            PG8_STAGE(PG8_SB(0, 1), b2 + hstep, voffB);
            PG8_WAIT_V(6); PG8_BAR; PG8_MMA(1, 1, At, B1); PG8_BAR;
            PG8_LDB(B0, 1, 0); PG8_SCHED; PG8_LDA(At, 1, 0); PG8_STAGE(PG8_SA(0, 1), a2 + hstep, voffA);
            PG8_WAIT_L(8); PG8_BAR; PG8_WAIT_L(0); PG8_MMA(0, 0, At, B0); PG8_BAR; PG8_SCHED;
            PG8_LDB(B1, 1, 1); PG8_STAGE(PG8_SB(1, 0), b3, voffB);
            PG8_BAR; PG8_WAIT_L(0); PG8_MMA(0, 1, At, B1); PG8_BAR;
            PG8_LDA(At, 1, 1); PG8_STAGE(PG8_SA(1, 0), a3, voffA);
            PG8_BAR; PG8_WAIT_L(0); PG8_MMA(1, 0, At, B0); PG8_BAR; PG8_SCHED;
            PG8_STAGE(PG8_SB(1, 1), b3 + hstep, voffB);
            PG8_WAIT_V(6); PG8_BAR; PG8_MMA(1, 1, At, B1); PG8_BAR;
        }
        PG8_STAMP();
        if constexpr (!Epi::AFTER_DRAIN) { E(acc, cur, wr, wc, fr, fq); S.done(cur); }
        PG8_STAMP();
        if (!has_next) break;
#pragma unroll
        for (int a = 0; a < 2; ++a)
#pragma unroll
            for (int b = 0; b < 2; ++b)
#pragma unroll
                for (int m = 0; m < 4; ++m)
#pragma unroll
                    for (int n = 0; n < 2; ++n) acc[a][b][m][n] = (f32x4){0.f, 0.f, 0.f, 0.f};
        cur = nxt; cA = nA; cB = nB; ++ui;
    }
    PG8_WAIT_V(0);
    if (wr == 0) PG8_BAR;
    PG8_BAR;
    if constexpr (Epi::AFTER_DRAIN) { E.fused(acc, cur, wr, wc, fr, fq, lds, wid, lane); S.done(cur); }
    PG8_STAMP();
    if (STAMP && wid == 0) { stamps[lane] = lane < nts ? (((unsigned long long)(unsigned)ts_hi << 32) | (unsigned)ts_lo) : 0ull;
        if (lane == 62) stamps[62] = rt_entry; if (lane == 63) stamps[63] = (unsigned long long)wall_clock64(); }
#undef PG8_STAMP
#undef PG8_SA
#undef PG8_SB
#undef PG8_STAGE
#undef PG8_LDA
#undef PG8_LDB
#undef PG8_MMA
#undef PG8_WAIT_V
#undef PG8_WAIT_L
#undef PG8_BAR
#undef PG8_SCHED
}
}
#define XB_TMO      128
#define XB_XCNT(j)  (256  + 64 * (j))
#define XB_XSUB(j)  (1280 + 64 * (j))
#define XB_XGEN(j)  (2304 + 64 * (j))
#define XB_TOP      3328
#define XB_TOPGEN   3392
#define XCD_BAR_WORDS 3456
#define XB_SPIN_CAP (1u << 22)
#define XLAS __attribute__((address_space(3)))

__device__ __forceinline__ unsigned xb_ld(unsigned* p)              { return __hip_atomic_load(p, __ATOMIC_RELAXED, __HIP_MEMORY_SCOPE_AGENT); }
__device__ __forceinline__ unsigned xb_add(unsigned* p, unsigned v) { return __hip_atomic_fetch_add(p, v, __ATOMIC_RELAXED, __HIP_MEMORY_SCOPE_AGENT); }
__device__ __forceinline__ unsigned xb_xcc_id() { return (unsigned)__builtin_amdgcn_s_getreg((3 << 11) | 20) & 0xFu; }
#define XB_SPIN(cond, bar) do { unsigned _sp = 0; while (cond) { __builtin_amdgcn_s_sleep(1); \
    if ((++_sp & 255u) == 0u) { if (xb_ld(&(bar)[XB_TMO])) break; if (_sp > XB_SPIN_CAP) { atomicAdd(&(bar)[XB_TMO], 1u); break; } } } } while (0)

struct XcdBarrier {
    unsigned* bar; unsigned x;
    volatile XLAS unsigned* st;
};

__device__ __forceinline__ XcdBarrier xcd_barrier_post(unsigned* bar, volatile XLAS unsigned* st) {
    XcdBarrier b; b.bar = bar; b.x = xb_xcc_id(); b.st = st;
    if (threadIdx.x == 0) (void)xb_add(&bar[XB_XCNT(b.x)], 1u);
    return b;
}
__device__ __forceinline__ void xcd_barrier_complete(unsigned* bar, unsigned x, unsigned& nloc, unsigned& nx) {
    const unsigned G = gridDim.x * gridDim.y * gridDim.z;
    unsigned sum, cnt, mine, sp = 0u;
    for (;;) {
        sum = 0u; cnt = 0u; mine = 0u;
#pragma unroll
        for (unsigned j = 0; j < 16; ++j) { const unsigned c = xb_ld(&bar[XB_XCNT(j)]); sum += c; cnt += (c > 0u) ? 1u : 0u; mine = (j == x) ? c : mine; }
        if (sum == G) break;
        __builtin_amdgcn_s_sleep(1);
        if ((++sp & 255u) == 0u) { if (xb_ld(&bar[XB_TMO])) break; if (sp > XB_SPIN_CAP) { atomicAdd(&bar[XB_TMO], 1u); break; } }
    }
    nloc = mine > 0u ? mine : 1u; nx = cnt > 0u ? cnt : 1u;
}

__device__ __forceinline__ void xcd_barrier(const XcdBarrier& b) {
    asm volatile("s_waitcnt vmcnt(0)" ::: "memory");
    __syncthreads();
    if (threadIdx.x == 0) {
        unsigned* bar = b.bar;
        __builtin_amdgcn_s_waitcnt(0);
        unsigned nloc = b.st[0], nx = b.st[1];
        if (nloc == 0u) { xcd_barrier_complete(bar, b.x, nloc, nx); b.st[0] = nloc; b.st[1] = nx; }
        const unsigned old = xb_add(&bar[XB_XSUB(b.x)], 1u);
        const unsigned gen = old / nloc;
        if (old + 1u == (gen + 1u) * nloc) {
            __builtin_amdgcn_fence(__ATOMIC_RELEASE, "agent");
            asm volatile("s_waitcnt vmcnt(0)" ::: "memory");
            const unsigned og = xb_add(&bar[XB_TOP], 1u);
            const unsigned tg = og / nx;
            if (og + 1u == (tg + 1u) * nx) xb_add(&bar[XB_TOPGEN], 1u);
            else XB_SPIN(xb_ld(&bar[XB_TOPGEN]) == tg, bar);
            __builtin_amdgcn_fence(__ATOMIC_ACQUIRE, "agent");
            xb_add(&bar[XB_XGEN(b.x)], 1u);
            asm volatile("s_waitcnt vmcnt(0)" ::: "memory");
        } else {
            XB_SPIN(xb_ld(&bar[XB_XGEN(b.x)]) == gen, bar);
            __builtin_amdgcn_fence(__ATOMIC_ACQUIRE, "agent");
            asm volatile("s_waitcnt vmcnt(0)" ::: "memory");
        }
    }
    __syncthreads();
}


using pg8::bf16_t; using pg8::bf16x8; using pg8::f32x4; using pg8::u32x4;
typedef float f32x2v __attribute__((ext_vector_type(2)));
typedef unsigned u32x2 __attribute__((ext_vector_type(2)));

constexpr int T = 16384, TP = 8192, D = 1024, NP = 4096, NL = 4;
constexpr float EPS = 1e-6f;
constexpr int C_RQ = 0, C_RK = 256, C_RV = 512, C_RG = 768, C_HY = 1024;
constexpr int C_GQ = 1792, C_GK = 2048, C_GV = 2304, C_GZ = 2560;
constexpr int C_SX = 2832, C_SB = 3088, C_SC = 3344, C_SZ = 3600;
constexpr int INC = 3864;

constexpr size_t WS_CTR = 0;
constexpr size_t WS_BAR = 4096;
constexpr size_t WS_MOD = 4096 + 16384;
constexpr size_t WS_GATE = WS_MOD + 491520;
constexpr size_t WS_X = WS_GATE + (size_t)T * 32 * 4;
constexpr size_t WS_H = WS_X + (size_t)T * D * 4;
constexpr size_t WS_P = WS_H + (size_t)T * D * 2;
constexpr size_t WS_MIX = WS_P + (size_t)T * NP * 2;
constexpr size_t WS_OB = WS_MIX + (size_t)T * D * 2;
constexpr size_t WS_WIN = WS_OB + (size_t)T * D * 2;
constexpr size_t WS_WOUT = WS_WIN + 8388608;
constexpr size_t WS_W1 = WS_WOUT + 2097152;
constexpr size_t WS_W2 = WS_W1 + 8388608;
constexpr size_t WBUF = 27262976;
constexpr size_t WS_TAPS = WS_W2 + 8388608 + WBUF;
constexpr int GT_CH = 4640, GT_SOFF = 528;
constexpr int TS = T + 64;
constexpr size_t WS_U = WS_TAPS + (size_t)4 * 256 * GT_CH * 2;
constexpr size_t WS_X0 = WS_U + (size_t)TS * 256 * 2;
constexpr size_t WS_Y = WS_X0 + (size_t)TS * 256 * 2;
constexpr size_t WS_END = WS_Y + (size_t)TS * 256 * 2;

constexpr size_t OUT_RET = (size_t)T * D, OUT_GDN = OUT_RET + 4194304, OUT_SSD = OUT_GDN + 4194304;

struct Params {
  const float *x_prompt, *x_sample, *state_ret, *state_gdn, *state_ssd, *c, *c_ctx;
  const float *norm1_w, *norm2_w, *w_mod, *b_mod, *w_in, *w_out, *ret_log_decay, *ret_norm_w;
  const float *hy_conv_w, *hy_conv_b, *hy_freq, *hy_w1, *hy_b1, *hy_w2, *hy_b2, *hy_w3, *hy_bias, *hy_norm_w;
  const float *gdn_conv_w, *gdn_A_log, *gdn_dt_bias, *gdn_norm_w;
  const float *ssd_conv_w, *ssd_conv_b, *ssd_A_log, *ssd_dt_bias, *ssd_D, *ssd_norm_w;
  const float *mlp_w1, *mlp_w2, *final_norm_w;
  float* out; unsigned char* ws;
};

__device__ __forceinline__ float wave_sum(float v) {
#pragma unroll
  for (int o = 32; o >= 1; o >>= 1) v += __shfl_xor(v, o);
  return v;
}
__device__ __forceinline__ bf16_t f2bf(float f) { unsigned u = __float_as_uint(f); u += 0x7FFFu + ((u >> 16) & 1u); return (bf16_t)(u >> 16); }
__device__ __forceinline__ float bf2f(bf16_t b) { return __uint_as_float(((unsigned)b) << 16); }
__device__ __forceinline__ unsigned pk2(float lo, float hi) { return pg8::cvt_pk_bf16(lo, hi); }
__device__ __forceinline__ float silu_f(float x) { return x * __builtin_amdgcn_rcpf(1.f + __expf(-x)); }
__device__ __forceinline__ float sigmoid_f(float x) { return __builtin_amdgcn_rcpf(1.f + __expf(-x)); }
__device__ __forceinline__ float softplus_f(float x) {
  if (x > 20.f) return x;
  const float e = __expf(x);
  return e < 0.01f ? e * (1.f - e * (0.5f - e * 0.33333334f)) : __logf(1.f + e);
}
__device__ __forceinline__ void ld8(const bf16_t* p, float (&o)[8]) {
  const u32x4 v = *(const u32x4*)p;
  o[0] = __uint_as_float(v.x << 16); o[1] = __uint_as_float(v.x & 0xffff0000u);
  o[2] = __uint_as_float(v.y << 16); o[3] = __uint_as_float(v.y & 0xffff0000u);
  o[4] = __uint_as_float(v.z << 16); o[5] = __uint_as_float(v.z & 0xffff0000u);
  o[6] = __uint_as_float(v.w << 16); o[7] = __uint_as_float(v.w & 0xffff0000u);
}
__device__ __forceinline__ void ldf8(const float* p, float (&o)[8]) {
  const f32x4 a = *(const f32x4*)p, b = *(const f32x4*)(p + 4);
  o[0] = a.x; o[1] = a.y; o[2] = a.z; o[3] = a.w; o[4] = b.x; o[5] = b.y; o[6] = b.z; o[7] = b.w;
}
__device__ __forceinline__ void st8bf(bf16_t* p, const float (&v)[8]) {
  u32x4 w; w.x = pk2(v[0], v[1]); w.y = pk2(v[2], v[3]); w.z = pk2(v[4], v[5]); w.w = pk2(v[6], v[7]);
  *(u32x4*)p = w;
}
__device__ __forceinline__ void conv8(const bf16_t* prow, int t, int L, const float* cw, const float* cb, float (&o)[8]) {
  float x[8], w[8];
  ld8(prow, x); ldf8(cw + 768, w);
  if (cb) { float b[8]; ldf8(cb, b);
#pragma unroll
    for (int e = 0; e < 8; ++e) o[e] = x[e] * w[e] + b[e];
  } else {
#pragma unroll
    for (int e = 0; e < 8; ++e) o[e] = x[e] * w[e];
  }
  if (t > 0) { ld8(prow - NP, x); ldf8(cw, w);
#pragma unroll
    for (int e = 0; e < 8; ++e) o[e] += x[e] * w[e]; }
  if (t < L - 1) { ld8(prow + NP, x); ldf8(cw + 1536, w);
#pragma unroll
    for (int e = 0; e < 8; ++e) o[e] += x[e] * w[e]; }
}
__device__ __forceinline__ void ld8v(u32x4 v, float (&o)[8]) {
  o[0] = __uint_as_float(v.x << 16); o[1] = __uint_as_float(v.x & 0xffff0000u); o[2] = __uint_as_float(v.y << 16); o[3] = __uint_as_float(v.y & 0xffff0000u);
  o[4] = __uint_as_float(v.z << 16); o[5] = __uint_as_float(v.z & 0xffff0000u); o[6] = __uint_as_float(v.w << 16); o[7] = __uint_as_float(v.w & 0xffff0000u); }
__device__ __forceinline__ void conv8b(const bf16_t* prow, int t, int L, const float* cw, const float* cb, float (&o)[8]) {
  const int dm = t > 0 ? -NP : 0, dp = t < L - 1 ? NP : 0;
  const float m0 = t > 0 ? 1.f : 0.f, m2 = t < L - 1 ? 1.f : 0.f;
  const u32x4 r0 = *(const u32x4*)(prow + dm), r1 = *(const u32x4*)prow, r2 = *(const u32x4*)(prow + dp);
  float x0[8], x1[8], x2[8], w0[8], w1[8], w2[8], b[8];
  ldf8(cw, w0); ldf8(cw + 768, w1); ldf8(cw + 1536, w2); ldf8(cb, b);
  ld8v(r0, x0); ld8v(r1, x1); ld8v(r2, x2);
#pragma unroll
  for (int e = 0; e < 8; ++e) o[e] = b[e] + x1[e] * w1[e] + m0 * (x0[e] * w0[e]) + m2 * (x2[e] * w2[e]);
}
__device__ __forceinline__ f32x4 mma_tile(const bf16_t* A, int lda, const bf16_t* Bt, int ldb, int K, f32x4 acc, int lane, int xa = 0, int xb = 0) {
  const bf16_t* ap = A + (lane & 15) * lda;
  const bf16_t* bp = Bt + (lane & 15) * ldb;
  const int kq = (lane >> 4) * 8;
  for (int k0 = 0; k0 < K; k0 += 32) {
    const bf16x8 a = *(const bf16x8*)(ap + ((k0 + kq) ^ xa)), b = *(const bf16x8*)(bp + ((k0 + kq) ^ xb));
    acc = __builtin_amdgcn_mfma_f32_16x16x32_bf16(a, b, acc, 0, 0, 0);
  }
  return acc;
}
__device__ __forceinline__ int next_task(unsigned* ctr, int* slot) {
  __syncthreads();
  if (threadIdx.x == 0) *slot = (int)atomicAdd(ctr, 1u);
  __syncthreads();
  return *(volatile int*)slot;
}
__device__ __forceinline__ const float* xrow_ptr(const Params& p, int layer, int row) {
  if (layer == 0) return row < TP ? p.x_prompt + (size_t)row * D : p.x_sample + (size_t)(row - TP) * D;
  return (const float*)(p.ws + WS_X) + (size_t)row * D;
}
__device__ __forceinline__ int cond_row(int row) { return row < TP ? 0 : 1 + ((row - TP) >> 11); }

struct EpiP {
  static constexpr bool PERM = true, AFTER_DRAIN = false;
  bf16_t* O; float* gates;
  __device__ __forceinline__ void operator()(const f32x4 (&acc)[2][2][4][2], const pg8::Unit& u, int wr, int wc, int fr, int fq) const {
    const int row0 = u.pm * 256 + wr * 64 + fr, col0 = u.pn * 256 + wc * 32 + 8 * fq;
#pragma unroll
    for (int ai = 0; ai < 2; ++ai)
#pragma unroll
      for (int m = 0; m < 4; ++m) {
        const int row = row0 + ai * 128 + m * 16;
#pragma unroll
        for (int bj = 0; bj < 2; ++bj) {
          const int col = col0 + bj * 128;
          const f32x4 v0 = acc[ai][bj][m][0], v1 = acc[ai][bj][m][1];
          u32x4 w; w.x = pk2(v0[0], v0[1]); w.y = pk2(v0[2], v0[3]); w.z = pk2(v1[0], v1[1]); w.w = pk2(v1[2], v1[3]);
          *(u32x4*)(O + (size_t)row * NP + col) = w;
          if (col >= 2816 && col < 2832) { float* g = gates + (size_t)row * 32 + (col - 2816); *(f32x4*)g = v0; *(f32x4*)(g + 4) = v1; }
          if (col == 3856) { float* g = gates + (size_t)row * 32 + 16; *(f32x4*)g = v0; *(f32x4*)(g + 4) = v1; }
        }
      }
  }
};
struct EpiRelu2 {
  static constexpr bool PERM = true, AFTER_DRAIN = false;
  bf16_t* O;
  __device__ __forceinline__ void operator()(const f32x4 (&acc)[2][2][4][2], const pg8::Unit& u, int wr, int wc, int fr, int fq) const {
    const int row0 = u.pm * 256 + wr * 64 + fr, col0 = u.pn * 256 + wc * 32 + 8 * fq;
#pragma unroll
    for (int ai = 0; ai < 2; ++ai)
#pragma unroll
      for (int m = 0; m < 4; ++m) {
        const int row = row0 + ai * 128 + m * 16;
#pragma unroll
        for (int bj = 0; bj < 2; ++bj) {
          const int col = col0 + bj * 128;
          f32x4 v0 = acc[ai][bj][m][0], v1 = acc[ai][bj][m][1];
#pragma unroll
          for (int j = 0; j < 4; ++j) { const float a = fmaxf(v0[j], 0.f), b = fmaxf(v1[j], 0.f); v0[j] = a * a; v1[j] = b * b; }
          u32x4 w; w.x = pk2(v0[0], v0[1]); w.y = pk2(v0[2], v0[3]); w.z = pk2(v1[0], v1[1]); w.w = pk2(v1[2], v1[3]);
          *(u32x4*)(O + (size_t)row * NP + col) = w;
        }
      }
  }
};
struct EpiRes {
  static constexpr bool PERM = false, AFTER_DRAIN = false;
  const float* xin_p; const float* xin_s; float* xout; const float* gate;
  __device__ __forceinline__ void operator()(const f32x4 (&acc)[2][2][4][2], const pg8::Unit& u, int wr, int wc, int fr, int fq) const {
    const int row0 = u.pm * 256 + wr * 64 + fr, col0 = u.pn * 256 + wc * 32 + 4 * fq;
    const float* gr = gate + (size_t)cond_row(u.pm * 256) * 6144 + col0;
    const float* xi0 = (u.pm * 256 < TP ? xin_p + (size_t)row0 * D : xin_s + (size_t)(row0 - TP) * D) + col0;
    float* xo0 = xout + (size_t)row0 * D + col0;
    f32x4 gv[2][2];
#pragma unroll
    for (int bj = 0; bj < 2; ++bj)
#pragma unroll
      for (int n = 0; n < 2; ++n) gv[bj][n] = *(const f32x4*)(gr + bj * 128 + n * 16);
    f32x4 xv[2][2][2];
#pragma unroll
    for (int bj = 0; bj < 2; ++bj)
#pragma unroll
      for (int n = 0; n < 2; ++n) xv[0][bj][n] = *(const f32x4*)(xi0 + bj * 128 + n * 16);
#pragma unroll
    for (int s = 0; s < 8; ++s) {
      const int ai = s >> 2, mm = s & 3;
      if (s < 7) { const int s1 = s + 1; const size_t off1 = (size_t)((s1 >> 2) * 128 + (s1 & 3) * 16) * D;
#pragma unroll
        for (int bj = 0; bj < 2; ++bj)
#pragma unroll
          for (int n = 0; n < 2; ++n) xv[(s + 1) & 1][bj][n] = *(const f32x4*)(xi0 + off1 + bj * 128 + n * 16); }
      const size_t off = (size_t)(ai * 128 + mm * 16) * D;
#pragma unroll
      for (int bj = 0; bj < 2; ++bj)
#pragma unroll
        for (int n = 0; n < 2; ++n) *(f32x4*)(xo0 + off + bj * 128 + n * 16) = xv[s & 1][bj][n] + gv[bj][n] * acc[ai][bj][mm][n];
    }
  }
};

__device__ __forceinline__ void phase0(const Params& p, unsigned char* lds) {
  int tid_l = threadIdx.x; asm volatile("" : "+v"(tid_l));
  const int tid = tid_l;
  float* mod = (float*)(p.ws + WS_MOD);
  if (blockIdx.x == 0) { if (tid < 64) ((unsigned*)(p.ws + WS_CTR))[tid] = 0u; for (int i = tid; i < XCD_BAR_WORDS; i += 512) ((unsigned*)(p.ws + WS_BAR))[i] = 0u; }
  float* sF = (float*)lds;
  constexpr int NMOD = NL * 48, NTAP = NL * 288;
  for (int task = blockIdx.x; task < NMOD + NTAP; task += gridDim.x) {
    __syncthreads();
    if (task < NMOD) {
      const int l = task / 48, cb = task % 48;
      float* sC = sF;
      float* sR = sF + 5120;
      for (int i = tid; i < 5120; i += 512) { const int r = i >> 10, k = i & 1023; const float v = (r == 0) ? p.c_ctx[k] : p.c[(r - 1) * 1024 + k]; sC[i] = silu_f(v); }
      __syncthreads();
      const int col = cb * 128 + (tid & 127), kq = tid >> 7;
      float a0 = 0.f, a1 = 0.f, a2 = 0.f, a3 = 0.f, a4 = 0.f;
      const float* wp = p.w_mod + ((size_t)l * 1024 + kq * 256) * 6144 + col;
#pragma unroll 8
      for (int k = 0; k < 256; ++k) {
        const float w = wp[(size_t)k * 6144]; const int kk = kq * 256 + k;
        a0 += sC[kk] * w; a1 += sC[1024 + kk] * w; a2 += sC[2048 + kk] * w; a3 += sC[3072 + kk] * w; a4 += sC[4096 + kk] * w;
      }
      float* rr = sR + kq * 640 + (tid & 127);
      rr[0] = a0; rr[128] = a1; rr[256] = a2; rr[384] = a3; rr[512] = a4;
      __syncthreads();
      if (tid < 128) {
        const float b = p.b_mod[l * 6144 + col];
#pragma unroll
        for (int r = 0; r < 5; ++r) mod[((size_t)l * 5 + r) * 6144 + col] = sR[r * 128 + tid] + sR[640 + r * 128 + tid] + sR[1280 + r * 128 + tid] + sR[1920 + r * 128 + tid] + b;
      }
    } else {
      const int tt = task - NMOD, l = tt / 288, g = tt % 288;
      const int L = g < 32 ? 256 : 2048, i0 = g < 32 ? g * 8 : (g - 32) * 8;
      float* sZ = sF;
      float* sH1 = sF + 288;
      float* sH2 = sF + 288 + 512;
      const int r8 = tid >> 6, j = tid & 63, i = i0 + r8;
      const float tn = (float)i / (float)(L - 1);
      if (j < 33) {
        float z;
        if (j == 0) z = tn;
        else {
          const int b = (j - 1) & 15;
          const float f = 1e-4f + (float)b * ((15.0f - 1e-4f) / 15.0f);
          const float wang = 6.283185307179586f * (float)i / (float)L;
          z = (j <= 16) ? cosf(f * wang) : -sinf(f * wang);
        }
        sZ[r8 * 36 + j] = z;
      }
      __syncthreads();
      const float fr = p.hy_freq[l * 64 + j];
      { float a = p.hy_b1[l * 64 + j];
        for (int e = 0; e < 33; ++e) a += sZ[r8 * 36 + e] * p.hy_w1[(l * 33 + e) * 64 + j];
        sH1[r8 * 64 + j] = sinf(fr * a); }
      __syncthreads();
      { float a = p.hy_b2[l * 64 + j];
        for (int e = 0; e < 64; ++e) a += sH1[r8 * 64 + e] * p.hy_w2[(l * 64 + e) * 64 + j];
        sH2[r8 * 64 + j] = sinf(fr * a); }
      __syncthreads();
      float acc[8];
#pragma unroll
      for (int r = 0; r < 8; ++r) acc[r] = 0.f;
      for (int e = 0; e < 64; ++e) {
        const float w = p.hy_w3[(l * 64 + e) * 512 + tid];
#pragma unroll
        for (int r = 0; r < 8; ++r) acc[r] += sH2[r * 64 + e] * w;
      }
      const int dir = tid >> 8, c = tid & 255;
      const float delta = 3.0701134573253944f + (float)c * ((15.350567286626973f - 3.0701134573253944f) / 255.0f);
      bf16_t* Gc = (bf16_t*)(p.ws + WS_TAPS) + ((size_t)l * 256 + c) * GT_CH + (L == 256 ? 0 : GT_SOFF);
#pragma unroll
      for (int r = 0; r < 8; ++r) {
        const int ii = i0 + r; const float tnr = (float)ii / (float)(L - 1);
        const float v = acc[r] * expf(-tnr * delta);
        if (dir == 0) Gc[L - ii] = f2bf(v);
        else if (ii >= 1) Gc[L + ii] = f2bf(v);
      }
    }
  }
}

constexpr int CV_IN = 16 * 64, CV_OUT = 16 * 16, CV_1 = 16 * 64, CV_2 = 64 * 16, CV_ALL = CV_IN + CV_OUT + CV_1 + CV_2;
__device__ __forceinline__ void convert_item4(const Params& p, int layer, int it0, float* sT) {
  unsigned char* wb = p.ws + (size_t)(layer & 1) * WBUF;
  const float* W; bf16_t* WT; int K, N, ntn, r = it0;
  if (r < CV_IN) { W = p.w_in + (size_t)layer * 1024 * INC; K = 1024; N = INC; WT = (bf16_t*)(wb + WS_WIN); ntn = 64; }
  else if ((r -= CV_IN) < CV_OUT) { W = p.w_out + (size_t)layer * 1024 * 1024; K = 1024; N = 1024; WT = (bf16_t*)(wb + WS_WOUT); ntn = 16; }
  else if ((r -= CV_OUT) < CV_1) { W = p.mlp_w1 + (size_t)layer * 1024 * 4096; K = 1024; N = 4096; WT = (bf16_t*)(wb + WS_W1); ntn = 64; }
  else { r -= CV_1; W = p.mlp_w2 + (size_t)layer * 4096 * 1024; K = 4096; N = 1024; WT = (bf16_t*)(wb + WS_W2); ntn = 16; }
  int tid_l = threadIdx.x; asm volatile("" : "+v"(tid_l));
  const int tid = tid_l;
  __syncthreads();
#pragma unroll
  for (int q = 0; q < 4; ++q) {
    const int tile = r + q, k0 = (tile / ntn) * 64, n0 = (tile % ntn) * 64;
#pragma unroll
    for (int i = 0; i < 8; ++i) {
      const int e = tid + i * 512, kk = e >> 6, nn = e & 63;
      sT[q * 4160 + kk * 65 + nn] = (n0 + nn < N) ? W[(size_t)(k0 + kk) * N + n0 + nn] : 0.f;
    }
  }
  __syncthreads();
  const int n = tid >> 3, kc = (tid & 7) * 8;
#pragma unroll
  for (int q = 0; q < 4; ++q) {
    const int tile = r + q, k0 = (tile / ntn) * 64, n0 = (tile % ntn) * 64;
    float v[8];
#pragma unroll
    for (int e = 0; e < 8; ++e) v[e] = sT[q * 4160 + (kc + e) * 65 + n];
    st8bf(WT + (size_t)(n0 + n) * K + k0 + kc, v);
  }
}
__device__ __forceinline__ void convert_weights(const Params& p, int layer, unsigned char* lds) {
  float* sT = (float*)lds;
  for (int it = blockIdx.x * 4; it < CV_ALL; it += gridDim.x * 4) convert_item4(p, layer, it, sT);
  __syncthreads();
}

__device__ __forceinline__ void norm_phase(const Params& p, int layer, int which  ) {
  int tid_l = threadIdx.x; asm volatile("" : "+v"(tid_l));
  const int lane = tid_l & 63, wv = tid_l >> 6;
  const float* nw = (which ? p.norm2_w : p.norm1_w) + layer * D;
  const float* mod = (const float*)(p.ws + WS_MOD) + (size_t)layer * 5 * 6144 + which * 3072;
  bf16_t* H = (bf16_t*)(p.ws + WS_H);
  for (int base = (blockIdx.x * 8 + wv) * 8; base < T; base += gridDim.x * 64) {
    const float* mr = mod + (size_t)cond_row(base) * 6144;
    f32x4 ws[4], sh[4];
#pragma unroll
    for (int j = 0; j < 4; ++j) { const int col = j * 256 + lane * 4; ws[j] = *(const f32x4*)(nw + col) * (*(const f32x4*)(mr + 1024 + col) + 1.f); sh[j] = *(const f32x4*)(mr + col); }
#pragma unroll
    for (int hf = 0; hf < 2; ++hf) {
      f32x4 v[4][4]; float ss[4];
#pragma unroll
      for (int i = 0; i < 4; ++i) { const int row = base + hf * 4 + i;
        const float* xr = which ? (const float*)(p.ws + WS_X) + (size_t)row * D : xrow_ptr(p, layer, row);
#pragma unroll
        for (int j = 0; j < 4; ++j) v[i][j] = *(const f32x4*)(xr + j * 256 + lane * 4); }
#pragma unroll
      for (int i = 0; i < 4; ++i) { float a = 0.f;
#pragma unroll
        for (int j = 0; j < 4; ++j) a += v[i][j].x * v[i][j].x + v[i][j].y * v[i][j].y + v[i][j].z * v[i][j].z + v[i][j].w * v[i][j].w;
        ss[i] = a; }
#pragma unroll
      for (int o = 32; o >= 1; o >>= 1) {
#pragma unroll
        for (int i = 0; i < 4; ++i) ss[i] += __shfl_xor(ss[i], o); }
#pragma unroll
      for (int i = 0; i < 4; ++i) { const int row = base + hf * 4 + i; const float rstd = rsqrtf(ss[i] * (1.f / D) + EPS);
#pragma unroll
        for (int j = 0; j < 4; ++j) { const f32x4 o = v[i][j] * rstd * ws[j] + sh[j];
          u32x2 pk; pk.x = pk2(o.x, o.y); pk.y = pk2(o.z, o.w);
          *(u32x2*)(H + (size_t)row * D + j * 256 + lane * 4) = pk; } }
    }
  }
}
__device__ __forceinline__ void final_norm(const Params& p) {
  int tid_l = threadIdx.x; asm volatile("" : "+v"(tid_l));
  const int lane = tid_l & 63, wv = tid_l >> 6;
  f32x4 w4[4];
#pragma unroll
  for (int j = 0; j < 4; ++j) w4[j] = *(const f32x4*)(p.final_norm_w + j * 256 + lane * 4);
  for (int base = (blockIdx.x * 8 + wv) * 8; base < T; base += gridDim.x * 64) {
#pragma unroll
    for (int hf = 0; hf < 2; ++hf) {
      f32x4 v[4][4]; float ss[4];
#pragma unroll
      for (int i = 0; i < 4; ++i) { const float* xr = (const float*)(p.ws + WS_X) + (size_t)(base + hf * 4 + i) * D;
#pragma unroll
        for (int j = 0; j < 4; ++j) v[i][j] = *(const f32x4*)(xr + j * 256 + lane * 4); }
#pragma unroll
      for (int i = 0; i < 4; ++i) { float a = 0.f;
#pragma unroll
        for (int j = 0; j < 4; ++j) a += v[i][j].x * v[i][j].x + v[i][j].y * v[i][j].y + v[i][j].z * v[i][j].z + v[i][j].w * v[i][j].w;
        ss[i] = a; }
#pragma unroll
      for (int o = 32; o >= 1; o >>= 1) {
#pragma unroll
        for (int i = 0; i < 4; ++i) ss[i] += __shfl_xor(ss[i], o); }
#pragma unroll
      for (int i = 0; i < 4; ++i) { const float rstd = rsqrtf(ss[i] * (1.f / D) + EPS);
#pragma unroll
        for (int j = 0; j < 4; ++j) *(f32x4*)(p.out + (size_t)(base + hf * 4 + i) * D + j * 256 + lane * 4) = v[i][j] * rstd * w4[j]; }
    }
  }
}

template <bool SSD>
__device__ __forceinline__ void decay_task(const Params& p, int layer, int seq, int head, int dir, unsigned char* lds) {
  constexpr int KD = SSD ? 128 : 64, LQ = KD + 8, NST = KD / 32;
  bf16_t* sQ = (bf16_t*)(lds + 64); bf16_t* sQs = sQ + 64 * LQ; bf16_t* sK = sQs + 64 * LQ; bf16_t* sSt = sK + 64 * LQ;
  bf16_t* sKdt = sSt + 64 * LQ; bf16_t* sVt = sKdt + KD * 72; bf16_t* sAtt = sVt + 64 * 72; bf16_t* sXs = sAtt + 64 * 72;
  float* sCum = (float*)(sXs + 64 * 72); float* sDt = sCum + 64; float* sCW = sDt + 64;
  const bf16_t* P = (const bf16_t*)(p.ws + WS_P);
  const float* gates = (const float*)(p.ws + WS_GATE);
  bf16_t* Odst = (bf16_t*)(p.ws + (dir ? WS_OB : WS_MIX));
  int tid_l = threadIdx.x; asm volatile("" : "+v"(tid_l));
  const int tid = tid_l, lane = tid & 63, w = tid >> 6, r = tid >> 3, sub = tid & 7;
  const bool sample = seq >= 32; const int L = sample ? 2048 : 256, seqbase = sample ? TP + (seq - 32) * 2048 : seq * 256, nch = L / 64;
  const int tr = w >> 1, tcs = (w & 1) * NST, tca = (w & 1) * 2;
  const int gidx = (layer * 2 + dir) * 4 + head;
  const int colbase = SSD ? 768 : 0;
  f32x4 accS[NST];
  if (sample) {
    const float* src = (SSD ? p.state_ssd : p.state_ret) + ((((size_t)(seq - 32) * 4 + layer) * 2 + dir) * 4 + head) * (KD * 64);
#pragma unroll
    for (int q = 0; q < NST; ++q) accS[q] = *(const f32x4*)(src + (16 * (tcs + q) + (lane & 15)) * 64 + 16 * tr + (lane >> 4) * 4);
  } else {
#pragma unroll
    for (int q = 0; q < NST; ++q) accS[q] = (f32x4){0.f, 0.f, 0.f, 0.f};
  }
  const float la_ret = SSD ? 0.f : p.ret_log_decay[gidx];
  const float Aneg = SSD ? -expf(p.ssd_A_log[gidx]) : 0.f, dtb = SSD ? p.ssd_dt_bias[gidx] : 0.f, Dh = SSD ? p.ssd_D[layer * 4 + head] : 0.f;
  const int grp = head >> 1;

  u32x4 xr[5][3]; float graw = 0.f;
  if constexpr (SSD) {
    const float* cw = p.ssd_conv_w + (size_t)layer * 3 * 768; const float* cb = p.ssd_conv_b + layer * 768;
    if (tid < 320) { const int g5 = tid >> 6, tap = (tid >> 4) & 3, c4 = tid & 15;
      const int chb = g5 == 0 ? head * 64 : (g5 <= 2 ? 256 + grp * 128 + (g5 - 1) * 64 : 512 + grp * 128 + (g5 - 3) * 64);
      *(f32x4*)(sCW + tid * 4) = *(const f32x4*)((tap < 3 ? cw + tap * 768 : cb) + chb + c4 * 4); }
    const int t0 = dir ? L - 1 - r : r, dm = t0 > 0 ? -NP : 0, dp = t0 < L - 1 ? NP : 0;
    const bf16_t* pr0 = P + (size_t)(seqbase + t0) * NP + C_SX + sub * 8;
    int gc[5]; gc[0] = head * 64; gc[1] = 256 + grp * 128; gc[2] = gc[1] + 64; gc[3] = 512 + grp * 128; gc[4] = gc[3] + 64;
#pragma unroll
    for (int g5 = 0; g5 < 5; ++g5) { const bf16_t* pc = pr0 + gc[g5]; xr[g5][0] = *(const u32x4*)(pc + dm); xr[g5][1] = *(const u32x4*)pc; xr[g5][2] = *(const u32x4*)(pc + dp); }
    if (tid < 64) { const int t2 = dir ? L - 1 - tid : tid; graw = gates[(size_t)(seqbase + t2) * 32 + 16 + dir * 4 + head]; }
    __syncthreads();
  }
  for (int n = 0; n < nch; ++n) {
    int tid_c = tid; asm volatile("" : "+v"(tid_c));
    const int tid = tid_c, lane = tid & 63, w = tid >> 6, r = tid >> 3, sub = tid & 7;
    const int tr = w >> 1, tcs = (w & 1) * NST, tca = (w & 1) * 2;
    const int pos = n * 64 + r, t = dir ? L - 1 - pos : pos;
    const bf16_t* prow = P + (size_t)(seqbase + t) * NP;
    float qv[KD / 64][8], kv[KD / 64][8], vv[8], xs[8];
    if constexpr (!SSD) {
      ld8(prow + C_RQ + head * 64 + sub * 8, qv[0]); ld8(prow + C_RK + head * 64 + sub * 8, kv[0]); ld8(prow + C_RV + head * 64 + sub * 8, vv);
#pragma unroll
      for (int e = 0; e < 8; ++e) kv[0][e] *= 0.125f;
      if (sample) {
        const float rowpos = (float)(t >> 6), colpos = (float)(t & 63);
#pragma unroll
        for (int e = 0; e < 8; ++e) {
          const int i = (sub & 3) * 8 + e;
          const float inv = exp2f(-(float)(i & 15) * (13.287712379549449f / 16.0f));
          const float ang = (i < 16 ? rowpos : colpos) * inv;
          float sn, cs; __sincosf(ang, &sn, &cs);
          const float oq = __shfl_xor(qv[0][e], 4), ok = __shfl_xor(kv[0][e], 4);
          if (sub < 4) { qv[0][e] = qv[0][e] * cs - oq * sn; kv[0][e] = kv[0][e] * cs - ok * sn; }
          else { qv[0][e] = oq * sn + qv[0][e] * cs; kv[0][e] = ok * sn + kv[0][e] * cs; }
        }
      }
    } else {
      const float m0 = t > 0 ? 1.f : 0.f, m2 = t < L - 1 ? 1.f : 0.f;
#pragma unroll
      for (int g5 = 0; g5 < 5; ++g5) {
        float x0[8], x1[8], x2[8], w0[8], w1[8], w2[8], bb[8];
        asm volatile("" : "+v"(xr[g5][0]), "+v"(xr[g5][1]), "+v"(xr[g5][2]));
        ldf8(sCW + (g5 * 4 + 0) * 64 + sub * 8, w0); ldf8(sCW + (g5 * 4 + 1) * 64 + sub * 8, w1); ldf8(sCW + (g5 * 4 + 2) * 64 + sub * 8, w2); ldf8(sCW + (g5 * 4 + 3) * 64 + sub * 8, bb);
        ld8v(xr[g5][0], x0); ld8v(xr[g5][1], x1); ld8v(xr[g5][2], x2);
#pragma unroll
        for (int e2 = 0; e2 < 8; ++e2) { float o = silu_f(bb[e2] + x1[e2] * w1[e2] + m0 * (x0[e2] * w0[e2]) + m2 * (x2[e2] * w2[e2]));
          asm volatile("" : "+v"(o));
          if (g5 == 0) xs[e2] = o; else if (g5 == 1) kv[0][e2] = o; else if (g5 == 2) kv[1][e2] = o; else if (g5 == 3) qv[0][e2] = o; else qv[1][e2] = o; }
        asm volatile("" ::: "memory");
      }
    }
    const float graw_c = graw;
    if constexpr (SSD) {
      if (n + 1 < nch) {
        const int pos1 = (n + 1) * 64 + r, t1 = dir ? L - 1 - pos1 : pos1, dm = t1 > 0 ? -NP : 0, dp = t1 < L - 1 ? NP : 0;
        const bf16_t* pr1 = P + (size_t)(seqbase + t1) * NP + C_SX + sub * 8;
        int gc[5]; gc[0] = head * 64; gc[1] = 256 + grp * 128; gc[2] = gc[1] + 64; gc[3] = 512 + grp * 128; gc[4] = gc[3] + 64;
#pragma unroll
        for (int g5 = 0; g5 < 5; ++g5) { const bf16_t* pc = pr1 + gc[g5]; xr[g5][0] = *(const u32x4*)(pc + dm); xr[g5][1] = *(const u32x4*)pc; xr[g5][2] = *(const u32x4*)(pc + dp); }
        if (tid < 64) { const int pos2 = (n + 1) * 64 + tid, t2 = dir ? L - 1 - pos2 : pos2; graw = gates[(size_t)(seqbase + t2) * 32 + 16 + dir * 4 + head]; }
      }
    }
    if (tid < 64) {
      float la, dtv = 0.f;
      if constexpr (SSD) {
        dtv = softplus_f(graw_c + dtb); la = Aneg * dtv;
      } else la = la_ret;
      float c = la;
#pragma unroll
      for (int o = 1; o < 64; o <<= 1) { const float y = __shfl_up(c, o); if (lane >= o) c += y; }
      sCum[tid] = c; sDt[tid] = dtv;
    }
    __syncthreads();
    const float cum_r = sCum[r], last = sCum[63];
    const float eq = __expf(cum_r), ek = __expf(last - cum_r);
    if constexpr (SSD) { const float dt_r = sDt[r];
#pragma unroll
      for (int e = 0; e < 8; ++e) vv[e] = xs[e] * dt_r;
      st8bf(sXs + r * 72 + sub * 8, xs); }
#pragma unroll
    for (int g = 0; g < KD / 64; ++g) {
      st8bf(sQ + r * LQ + g * 64 + sub * 8, qv[g]); st8bf(sK + r * LQ + g * 64 + sub * 8, kv[g]);
      float qs[8];
#pragma unroll
      for (int e = 0; e < 8; ++e) { qs[e] = qv[g][e] * eq; sKdt[(g * 64 + sub * 8 + e) * 72 + (r ^ ((sub >> 1) << 4))] = f2bf(kv[g][e] * ek); }
      st8bf(sQs + r * LQ + g * 64 + sub * 8, qs);
    }
#pragma unroll
    for (int e = 0; e < 8; ++e) sVt[(sub * 8 + e) * 72 + (r ^ ((sub >> 1) << 4))] = f2bf(vv[e]);
#pragma unroll
    for (int q = 0; q < NST; ++q)
#pragma unroll
      for (int j = 0; j < 4; ++j) sSt[(16 * tr + (lane >> 4) * 4 + j) * LQ + 16 * (tcs + q) + (lane & 15)] = f2bf(accS[q][j]);
    __syncthreads();
    f32x4 accO[2];
#pragma unroll
    for (int c2 = 0; c2 < 2; ++c2) {
      const int tc = tca + c2;
      f32x4 a = mma_tile(sQ + 16 * tr * LQ, LQ, sK + 16 * tc * LQ, LQ, KD, (f32x4){0.f, 0.f, 0.f, 0.f}, lane);
      accO[c2] = mma_tile(sQs + 16 * tr * LQ, LQ, sSt + 16 * tc * LQ, LQ, KD, (f32x4){0.f, 0.f, 0.f, 0.f}, lane);
      const int jj = 16 * tc + (lane & 15); const float cj = sCum[jj];
#pragma unroll
      for (int j = 0; j < 4; ++j) { const int i = 16 * tr + (lane >> 4) * 4 + j;
        const float val = (jj <= i) ? a[j] * __expf(sCum[i] - cj) : 0.f; sAtt[i * 72 + jj] = f2bf(val); }
    }
    __syncthreads();
#pragma unroll
    for (int c2 = 0; c2 < 2; ++c2) {
      const int tc = tca + c2;
      accO[c2] = mma_tile(sAtt + 16 * tr * 72, 72, sVt + 16 * tc * 72, 72, 64, accO[c2], lane, 0, (tc & 3) << 4);
      const int v = 16 * tc + (lane & 15);
#pragma unroll
      for (int j = 0; j < 4; ++j) { const int i = 16 * tr + (lane >> 4) * 4 + j;
        float o = accO[c2][j];
        if constexpr (SSD) { if (dir == 0) o += bf2f(sXs[i * 72 + v]) * Dh; }
        sQ[i * LQ + v] = f2bf(o); }
    }
    const float el = __expf(last);
#pragma unroll
    for (int q = 0; q < NST; ++q) { accS[q] = accS[q] * el; accS[q] = mma_tile(sVt + 16 * tr * 72, 72, sKdt + 16 * (tcs + q) * 72, 72, 64, accS[q], lane, (tr & 3) << 4, ((tcs + q) & 3) << 4); }
    __syncthreads();
    *(u32x4*)(Odst + (size_t)(seqbase + t) * D + colbase + head * 64 + sub * 8) = *(const u32x4*)(sQ + r * LQ + sub * 8);
  }
  if (!sample) {
    float* dst = p.out + (SSD ? OUT_SSD : OUT_RET) + ((((size_t)seq * 4 + layer) * 2 + dir) * 4 + head) * (KD * 64);
#pragma unroll
    for (int q = 0; q < NST; ++q) *(f32x4*)(dst + (16 * (tcs + q) + (lane & 15)) * 64 + 16 * tr + (lane >> 4) * 4) = accS[q];
  }
}

__device__ __forceinline__ void unpk8(u32x4 v, float (&o)[8]) {
  o[0] = __uint_as_float(v.x << 16); o[1] = __uint_as_float(v.x & 0xffff0000u); o[2] = __uint_as_float(v.y << 16); o[3] = __uint_as_float(v.y & 0xffff0000u);
  o[4] = __uint_as_float(v.z << 16); o[5] = __uint_as_float(v.z & 0xffff0000u); o[6] = __uint_as_float(v.w << 16); o[7] = __uint_as_float(v.w & 0xffff0000u); }
template <int OFF> __device__ __forceinline__ f32x4 lds_rd128(unsigned addr) { f32x4 v; asm volatile("ds_read_b128 %0, %1 offset:%2" : "=v"(v) : "v"(addr), "n"(OFF)); return v; }
template <int J> struct SolveStep {
  static __device__ __forceinline__ void run(f32x2v (&rr2)[8], f32x4 (&Ac)[4], unsigned apaddr, int part) {
    constexpr int mj = J >> 2, pj = J & 3, ip = mj >> 1, ie = mj & 1;
    f32x4 An[4];
    if constexpr (J < 62) {
      An[0] = lds_rd128<(J + 1) * 272 + 0>(apaddr); An[1] = lds_rd128<(J + 1) * 272 + 16>(apaddr); An[2] = lds_rd128<(J + 1) * 272 + 32>(apaddr); An[3] = lds_rd128<(J + 1) * 272 + 48>(apaddr);
      asm volatile("s_waitcnt lgkmcnt(4)" : "+v"(Ac[0]), "+v"(Ac[1]), "+v"(Ac[2]), "+v"(Ac[3]));
    } else {
      asm volatile("s_waitcnt lgkmcnt(0)" : "+v"(Ac[0]), "+v"(Ac[1]), "+v"(Ac[2]), "+v"(Ac[3]));
    }
    const float xj = __int_as_float(__builtin_amdgcn_mov_dpp(__float_as_int(rr2[ip][ie]), pj * 0x55, 0xf, 0xf, false));
    rr2[ip][ie] -= (part > pj ? Ac[mj >> 2][mj & 3] : 0.f) * xj;
    if constexpr (ie == 0) rr2[ip][1] -= Ac[(mj + 1) >> 2][(mj + 1) & 3] * xj;
    const f32x2v x2 = (f32x2v){xj, xj};
#pragma unroll
    for (int i = ip + 1; i < 8; ++i) {
      const f32x2v a2 = (i & 1) ? __builtin_shufflevector(Ac[i >> 1], Ac[i >> 1], 2, 3) : __builtin_shufflevector(Ac[i >> 1], Ac[i >> 1], 0, 1);
      rr2[i] = rr2[i] - a2 * x2;
    }
    if constexpr (J < 62) SolveStep<J + 1>::run(rr2, An, apaddr, part);
  }
};
template <int K> __device__ __forceinline__ float quad_bcast(float v) { return __int_as_float(__builtin_amdgcn_mov_dpp(__float_as_int(v), K * 0x55, 0xf, 0xf, false)); }
__device__ __forceinline__ void gdn_task(const Params& p, int layer, int seq, int head, int dir, unsigned char* lds) {
  constexpr int LQ = 72;
  bf16_t* sQ = (bf16_t*)(lds + 64); bf16_t* sQs = sQ + 64 * LQ; bf16_t* sK = sQs + 64 * LQ; bf16_t* sSt = sK + 64 * LQ;
  bf16_t* sKdt = sSt + 64 * LQ; bf16_t* sAtt = sKdt + 64 * LQ; bf16_t* sVNt = sAtt + 64 * LQ; bf16_t* sW = sVNt + 64 * LQ;
  float* sA = (float*)(sW + 64 * LQ);
  float* sR = sA + 64 * 68;
  float* sCum = sR + 64 * 132; float* sBeta = sCum + 64; float* sCW = sBeta + 64;
  const bf16_t* P = (const bf16_t*)(p.ws + WS_P);
  const float* gates = (const float*)(p.ws + WS_GATE);
  bf16_t* Odst = (bf16_t*)(p.ws + (dir ? WS_OB : WS_MIX));
  int tid_l = threadIdx.x; asm volatile("" : "+v"(tid_l));
  const int tid0 = tid_l;
  const bool sample = seq >= 32; const int L = sample ? 2048 : 256, seqbase = sample ? TP + (seq - 32) * 2048 : seq * 256, nch = L / 64;
  int tr, tca, lane;
  { const int w0 = tid0 >> 6; tr = w0 >> 1; tca = (w0 & 1) * 2; lane = tid0 & 63; }
  const int gidx = (layer * 2 + dir) * 4 + head;
  f32x4 accS[2];
  if (sample) {
    const float* src = p.state_gdn + ((((size_t)(seq - 32) * 4 + layer) * 2 + dir) * 4 + head) * 4096;
#pragma unroll
    for (int q = 0; q < 2; ++q) accS[q] = *(const f32x4*)(src + (16 * (tca + q) + (lane & 15)) * 64 + 16 * tr + (lane >> 4) * 4);
  } else {
#pragma unroll
    for (int q = 0; q < 2; ++q) accS[q] = (f32x4){0.f, 0.f, 0.f, 0.f};
  }
  const float Aneg = -expf(p.gdn_A_log[gidx]), dtb = p.gdn_dt_bias[gidx];
  const float* cw = p.gdn_conv_w + (size_t)layer * 3 * 768;

  const bf16_t* Pseq = P + (size_t)seqbase * NP + C_GQ + head * 64;
  if (tid0 < 144) { const int a3 = tid0 / 48, tap = (tid0 % 48) >> 4, c4 = tid0 & 15; *(f32x4*)(sCW + tid0 * 4) = *(const f32x4*)(cw + tap * 768 + a3 * 256 + head * 64 + c4 * 4); }
  u32x4 xr[3][3]; float ga = 0.f, gb = 0.f;
  { const int r0 = tid0 >> 3, pos0 = r0, t0 = dir ? L - 1 - pos0 : pos0, tm = t0 > 0 ? t0 - 1 : 0, tp = t0 < L - 1 ? t0 + 1 : L - 1;
    const bf16_t* pb = Pseq + (tid0 & 7) * 8;
#pragma unroll
    for (int a3 = 0; a3 < 3; ++a3) { xr[a3][0] = *(const u32x4*)(pb + (size_t)tm * NP + a3 * 256); xr[a3][1] = *(const u32x4*)(pb + (size_t)t0 * NP + a3 * 256); xr[a3][2] = *(const u32x4*)(pb + (size_t)tp * NP + a3 * 256); }
    if (tid0 < 64) { const int t2 = dir ? L - 1 - tid0 : tid0; const float* gr = gates + (size_t)(seqbase + t2) * 32; ga = gr[dir * 4 + head]; gb = gr[8 + dir * 4 + head]; } }
  __syncthreads();
  for (int n = 0; n < nch; ++n) {
    int tid_c = tid0; asm volatile("" : "+v"(tid_c));
    const int tid = tid_c, r = tid >> 3, sub = tid & 7;
    lane = tid & 63; { const int w1 = tid >> 6; tr = w1 >> 1; tca = (w1 & 1) * 2; }
    const int pos = n * 64 + r, t = dir ? L - 1 - pos : pos;
    float qv[8], kv[8], vv[8];
    { const float m0 = t > 0 ? 1.f : 0.f, m2 = t < L - 1 ? 1.f : 0.f;
#pragma unroll
      for (int a3 = 0; a3 < 3; ++a3) {
        float x0[8], x1[8], x2[8], w0[8], w1[8], w2[8];
        unpk8(xr[a3][0], x0); unpk8(xr[a3][1], x1); unpk8(xr[a3][2], x2);
        ldf8(sCW + (a3 * 3 + 0) * 64 + sub * 8, w0); ldf8(sCW + (a3 * 3 + 1) * 64 + sub * 8, w1); ldf8(sCW + (a3 * 3 + 2) * 64 + sub * 8, w2);
#pragma unroll
        for (int e2 = 0; e2 < 8; ++e2) { const float o = x1[e2] * w1[e2] + m0 * (x0[e2] * w0[e2]) + m2 * (x2[e2] * w2[e2]); if (a3 == 0) qv[e2] = o; else if (a3 == 1) kv[e2] = o; else vv[e2] = o; }
      } }
    const float ga_c = ga, gb_c = gb;
    if (n + 1 < nch) {
      const int pos1 = (n + 1) * 64 + r, t1 = dir ? L - 1 - pos1 : pos1, tm = t1 > 0 ? t1 - 1 : 0, tp = t1 < L - 1 ? t1 + 1 : L - 1;
      const bf16_t* pb = Pseq + sub * 8;
#pragma unroll
      for (int a3 = 0; a3 < 3; ++a3) { xr[a3][0] = *(const u32x4*)(pb + (size_t)tm * NP + a3 * 256); xr[a3][1] = *(const u32x4*)(pb + (size_t)t1 * NP + a3 * 256); xr[a3][2] = *(const u32x4*)(pb + (size_t)tp * NP + a3 * 256); }
      if (tid < 64) { const int pos2 = (n + 1) * 64 + tid, t2 = dir ? L - 1 - pos2 : pos2; const float* gr = gates + (size_t)(seqbase + t2) * 32; ga = gr[dir * 4 + head]; gb = gr[8 + dir * 4 + head]; }
    }
    float sq = 0.f, sk = 0.f;
#pragma unroll
    for (int e = 0; e < 8; ++e) { qv[e] = silu_f(qv[e]); kv[e] = silu_f(kv[e]); vv[e] = silu_f(vv[e]); sq += qv[e] * qv[e]; sk += kv[e] * kv[e]; }
    sq += __shfl_xor(sq, 1); sq += __shfl_xor(sq, 2); sq += __shfl_xor(sq, 4);
    sk += __shfl_xor(sk, 1); sk += __shfl_xor(sk, 2); sk += __shfl_xor(sk, 4);
    const float rq = rsqrtf(sq + EPS) * 0.125f, rk = rsqrtf(sk + EPS);
#pragma unroll
    for (int e = 0; e < 8; ++e) { qv[e] *= rq; kv[e] *= rk; }
    if (tid < 64) {
      const float la = Aneg * softplus_f(ga_c + dtb);
      float c = la;
#pragma unroll
      for (int o = 1; o < 64; o <<= 1) { const float y = __shfl_up(c, o); if (lane >= o) c += y; }
      sCum[tid] = c; sBeta[tid] = sigmoid_f(gb_c);
    }
    __syncthreads();
    const float cum_r = sCum[r], last = sCum[63], beta_r = sBeta[r];
    const float eq = __expf(cum_r), ek = __expf(last - cum_r);
    st8bf(sQ + r * LQ + sub * 8, qv); st8bf(sK + r * LQ + sub * 8, kv);
    { float qs[8];
#pragma unroll
      for (int e = 0; e < 8; ++e) { qs[e] = qv[e] * eq; sKdt[(sub * 8 + e) * LQ + (r ^ ((sub >> 1) << 4))] = f2bf(kv[e] * ek);
        sR[r * 132 + sub * 8 + e] = kv[e] * (beta_r * eq); sR[r * 132 + 64 + sub * 8 + e] = vv[e] * beta_r; }
      st8bf(sQs + r * LQ + sub * 8, qs); }
#pragma unroll
    for (int q = 0; q < 2; ++q)
#pragma unroll
      for (int j = 0; j < 4; ++j) sSt[(16 * tr + (lane >> 4) * 4 + j) * LQ + 16 * (tca + q) + (lane & 15)] = f2bf(accS[q][j]);
    __syncthreads();
    f32x4 accO[2];
#pragma unroll
    for (int c2 = 0; c2 < 2; ++c2) {
      const int tc = tca + c2;
      const f32x4 kk = mma_tile(sK + 16 * tr * LQ, LQ, sK + 16 * tc * LQ, LQ, 64, (f32x4){0.f, 0.f, 0.f, 0.f}, lane);
      const f32x4 qk = mma_tile(sQ + 16 * tr * LQ, LQ, sK + 16 * tc * LQ, LQ, 64, (f32x4){0.f, 0.f, 0.f, 0.f}, lane);
      accO[c2] = mma_tile(sQs + 16 * tr * LQ, LQ, sSt + 16 * tc * LQ, LQ, 64, (f32x4){0.f, 0.f, 0.f, 0.f}, lane);
      const int jj = 16 * tc + (lane & 15); const float cj = sCum[jj];
#pragma unroll
      for (int j = 0; j < 4; ++j) { const int i = 16 * tr + (lane >> 4) * 4 + j;
        const float dec = (jj <= i) ? __expf(sCum[i] - cj) : 0.f;
        sA[jj * 68 + (i & 3) * 16 + (i >> 2)] = (jj < i) ? kk[j] * dec * sBeta[i] : 0.f;
        sAtt[i * LQ + jj] = f2bf(qk[j] * dec); }
    }
    __syncthreads();
    {
      int tid_s = tid0; asm volatile("" : "+v"(tid_s));
      const int col = tid_s >> 2, part = tid_s & 3;
      float* rb = sR + part * 132 + col;
      const unsigned apaddr = (unsigned)(size_t)(XLAS float*)(sA + part * 16);
      f32x2v rr2[8];
#pragma unroll
      for (int m = 0; m < 16; ++m) rr2[m >> 1][m & 1] = rb[m * 528];
      asm volatile("s_waitcnt lgkmcnt(0)" ::: "memory");
      f32x4 A0[4];
      A0[0] = lds_rd128<0>(apaddr); A0[1] = lds_rd128<16>(apaddr); A0[2] = lds_rd128<32>(apaddr); A0[3] = lds_rd128<48>(apaddr);
      SolveStep<0>::run(rr2, A0, apaddr, part);
      float rr[16];
#pragma unroll
      for (int m = 0; m < 16; ++m) rr[m] = rr2[m >> 1][m & 1];
      if (col < 64) {
        bf16_t* wb = sW + part * LQ + col;
#pragma unroll
        for (int m = 0; m < 16; ++m) wb[m * 4 * LQ] = f2bf(rr[m]);
      } else {
#pragma unroll
        for (int m = 0; m < 16; ++m) rb[m * 528] = rr[m];
      }
    }
    __syncthreads();
    { int tid_p = tid0; asm volatile("" : "+v"(tid_p)); lane = tid_p & 63; const int w2 = tid_p >> 6; tr = w2 >> 1; tca = (w2 & 1) * 2; }
#pragma unroll
    for (int c2 = 0; c2 < 2; ++c2) {
      const int tc = tca + c2;
      const f32x4 ws = mma_tile(sW + 16 * tr * LQ, LQ, sSt + 16 * tc * LQ, LQ, 64, (f32x4){0.f, 0.f, 0.f, 0.f}, lane);
      const int v = 16 * tc + (lane & 15);
#pragma unroll
      for (int j = 0; j < 4; ++j) { const int cI = 16 * tr + (lane >> 4) * 4 + j; sVNt[v * LQ + cI] = f2bf(sR[cI * 132 + 64 + v] - ws[j]); }
    }
    __syncthreads();
#pragma unroll
    for (int c2 = 0; c2 < 2; ++c2) {
      const int tc = tca + c2;
      accO[c2] = mma_tile(sAtt + 16 * tr * LQ, LQ, sVNt + 16 * tc * LQ, LQ, 64, accO[c2], lane);
      const int v = 16 * tc + (lane & 15);
#pragma unroll
      for (int j = 0; j < 4; ++j) { const int i = 16 * tr + (lane >> 4) * 4 + j;
        sQ[i * LQ + v] = f2bf(accO[c2][j]); }
    }
    const float el = __expf(last);
#pragma unroll
    for (int q = 0; q < 2; ++q) { accS[q] = accS[q] * el; accS[q] = mma_tile(sVNt + 16 * tr * LQ, LQ, sKdt + 16 * (tca + q) * LQ, LQ, 64, accS[q], lane, 0, ((tca + q) & 3) << 4); }
    __syncthreads();
    { int tid_o = tid0; asm volatile("" : "+v"(tid_o)); const int ro = tid_o >> 3, so = tid_o & 7, po = n * 64 + ro, to = dir ? L - 1 - po : po;
      *(u32x4*)(Odst + (size_t)(seqbase + to) * D + 512 + head * 64 + so * 8) = *(const u32x4*)(sQ + ro * LQ + so * 8); }
  }
  if (!sample) {
    float* dst = p.out + OUT_GDN + ((((size_t)seq * 4 + layer) * 2 + dir) * 4 + head) * 4096;
#pragma unroll
    for (int q = 0; q < 2; ++q) *(f32x4*)(dst + (16 * (tca + q) + (lane & 15)) * 64 + 16 * tr + (lane >> 4) * 4) = accS[q];
  }
}

__device__ __forceinline__ void unpk4(u32x2 v, float (&o)[4]) { o[0] = __uint_as_float(v.x << 16); o[1] = __uint_as_float(v.x & 0xffff0000u); o[2] = __uint_as_float(v.y << 16); o[3] = __uint_as_float(v.y & 0xffff0000u); }
__device__ __forceinline__ void hy1_task(const Params& p, int layer, int g, unsigned char* lds) {
  const bf16_t* P = (const bf16_t*)(p.ws + WS_P);
  bf16_t* Ut = (bf16_t*)(p.ws + WS_U); bf16_t* X0t = (bf16_t*)(p.ws + WS_X0);
  bf16_t* sTu = (bf16_t*)(lds + 64); bf16_t* sTx = sTu + 256 * 72;
  int tid_l = threadIdx.x; asm volatile("" : "+v"(tid_l));
  const int tid = tid_l, r = tid >> 3, sub = tid & 7;
  const int row = g * 64 + r;
  const bool sample = row >= TP; const int L = sample ? 2048 : 256, t = sample ? (row - TP) & 2047 : row & 255;
  const bf16_t* prow = P + (size_t)row * NP + C_HY;
  const float* cw = p.hy_conv_w + (size_t)layer * 3 * 768; const float* cb = p.hy_conv_b + layer * 768;
#pragma unroll
  for (int q = 0; q < 4; ++q) {
    const int ch = q * 64 + sub * 8;
    float x0[8], x1[8], v[8];
    conv8(prow + ch, t, L, cw + ch, cb + ch, x0); conv8(prow + 256 + ch, t, L, cw + 256 + ch, cb + 256 + ch, x1); conv8(prow + 512 + ch, t, L, cw + 512 + ch, cb + 512 + ch, v);
#pragma unroll
    for (int e = 0; e < 8; ++e) { sTu[(ch + e) * 72 + (r ^ ((sub >> 1) << 4))] = f2bf(v[e] * x1[e]); sTx[(ch + e) * 72 + (r ^ ((sub >> 1) << 4))] = f2bf(x0[e]); }
  }
  __syncthreads();
  const int c = tid >> 1, h = tid & 1;
#pragma unroll
  for (int i = 0; i < 4; ++i) {
    *(u32x4*)(Ut + (size_t)c * TS + g * 64 + h * 32 + i * 8) = *(const u32x4*)(sTu + c * 72 + ((h * 32 + i * 8) ^ (((c >> 4) & 3) << 4)));
    *(u32x4*)(X0t + (size_t)c * TS + g * 64 + h * 32 + i * 8) = *(const u32x4*)(sTx + c * 72 + ((h * 32 + i * 8) ^ (((c >> 4) & 3) << 4)));
  }
}

template <bool SAMPLE>
__device__ __forceinline__ void hy2_task(const Params& p, int layer, int c, unsigned char* lds) {
  constexpr int L = SAMPLE ? 2048 : 256, GL = 2 * L + 8, CSE = SAMPLE ? 4112 : 528, NE = L / 32;
  const int rowbase = SAMPLE ? TP : 0;
  bf16_t* sU = (bf16_t*)(lds + 64);
  bf16_t* sG = sU + 8192;
  bf16_t* sRaw = sG + 8 * CSE;
  int tid_l = threadIdx.x; asm volatile("" : "+v"(tid_l));
  const int tid = tid_l, lane = tid & 63, w = tid >> 6, q = lane >> 4, n = lane & 15;
  const bf16_t* Uc = (const bf16_t*)(p.ws + WS_U) + (size_t)c * TS + rowbase;
  const bf16_t* Gc = (const bf16_t*)(p.ws + WS_TAPS) + ((size_t)layer * 256 + c) * GT_CH + (SAMPLE ? GT_SOFF : 0);
#pragma unroll
  for (int i = 0; i < 2; ++i) *(u32x4*)(sU + (tid + i * 512) * 8) = *(const u32x4*)(Uc + (tid + i * 512) * 8);
  for (int v8 = tid; v8 < (GL + 8) / 8; v8 += 512) {
    u32x4 gv = *(const u32x4*)(Gc + v8 * 8);
    if (v8 == 0) gv.x &= 0xffff0000u;
    if (v8 * 8 >= 2 * L) gv = (u32x4){0u, 0u, 0u, 0u};
    *(u32x4*)(sRaw + v8 * 8) = gv;
  }
  __syncthreads();
  for (int idx = tid; idx < CSE; idx += 512) {
#pragma unroll
    for (int a = 0; a < 8; ++a) sG[a * CSE + idx] = (idx + a < GL + 8) ? sRaw[idx + a] : (bf16_t)0;
  }
  __syncthreads();
  f32x4 acc[2][2];
#pragma unroll
  for (int g = 0; g < 2; ++g)
#pragma unroll
    for (int rh = 0; rh < 2; ++rh) acc[g][rh] = (f32x4){0.f, 0.f, 0.f, 0.f};
  const int dlo = SAMPLE ? 8 * w - 63 : w - 7, dhi = SAMPLE ? 8 * w + 7 : w;
#pragma unroll 2
  for (int dp = dlo; dp <= dhi; ++dp) {
    bf16x8 fa[2];
#pragma unroll
    for (int rh = 0; rh < 2; ++rh) { const int m0 = L - 32 * dp - (16 * rh + n) + 8 * q; fa[rh] = *(const bf16x8*)(sG + (m0 & 7) * CSE + (m0 & ~7)); }
#pragma unroll
    for (int g = 0; g < 2; ++g) {
      const int a = SAMPLE ? 8 * w + 4 * g + (n >> 2) : w, b = SAMPLE ? (n & 3) : 16 * g + n;
      const int e = a - dp;
      bf16x8 fb = (bf16x8){0, 0, 0, 0, 0, 0, 0, 0};
      if ((unsigned)e < (unsigned)NE) fb = *(const bf16x8*)(sU + b * L + 32 * e + 8 * q);
      acc[g][0] = __builtin_amdgcn_mfma_f32_16x16x32_bf16(fa[0], fb, acc[g][0], 0, 0, 0);
      acc[g][1] = __builtin_amdgcn_mfma_f32_16x16x32_bf16(fa[1], fb, acc[g][1], 0, 0, 0);
    }
  }
  const float hb = p.hy_bias[layer * 256 + c];
  bf16_t* Yc = (bf16_t*)(p.ws + WS_Y) + (size_t)c * TS + rowbase;
  const bf16_t* Xc = (const bf16_t*)(p.ws + WS_X0) + (size_t)c * TS + rowbase;
#pragma unroll
  for (int g = 0; g < 2; ++g) {
    const int a = SAMPLE ? 8 * w + 4 * g + (n >> 2) : w, b = SAMPLE ? (n & 3) : 16 * g + n;
#pragma unroll
    for (int rh = 0; rh < 2; ++rh) {
      const int lrow = b * L + 32 * a + 16 * rh + q * 4;
      float u[4], x0[4];
      unpk4(*(const u32x2*)(sU + lrow), u); unpk4(*(const u32x2*)(Xc + lrow), x0);
      u32x2 o; o.x = pk2(x0[0] * (acc[g][rh][0] + u[0] * hb), x0[1] * (acc[g][rh][1] + u[1] * hb)); o.y = pk2(x0[2] * (acc[g][rh][2] + u[2] * hb), x0[3] * (acc[g][rh][3] + u[3] * hb));
      *(u32x2*)(Yc + lrow) = o;
    }
  }
}

__device__ __forceinline__ void finalize_rows(const Params& p, int layer, unsigned char* lds) {
  const bf16_t* P = (const bf16_t*)(p.ws + WS_P);
  bf16_t* MIX = (bf16_t*)(p.ws + WS_MIX); const bf16_t* OB = (const bf16_t*)(p.ws + WS_OB);
  const bf16_t* Yt = (const bf16_t*)(p.ws + WS_Y);
  bf16_t* sY = (bf16_t*)(lds + 64);
  int tid_l = threadIdx.x; asm volatile("" : "+v"(tid_l));
  const int tid = tid_l, lane = tid & 63, wv = tid >> 6, c4 = lane * 4;
  const f32x4 w_ret = *(const f32x4*)(p.ret_norm_w + layer * 256 + c4), w_hy = *(const f32x4*)(p.hy_norm_w + layer * 256 + c4);
  const f32x4 w_gdn = *(const f32x4*)(p.gdn_norm_w + layer * 256 + c4), w_ssd = *(const f32x4*)(p.ssd_norm_w + layer * 256 + c4);
  for (int tile = blockIdx.x; tile < T / 64; tile += gridDim.x) {
    __syncthreads();
    { const int c = tid >> 1, h = tid & 1;
#pragma unroll
      for (int i = 0; i < 4; ++i) *(u32x4*)(sY + c * 72 + h * 32 + i * 8) = *(const u32x4*)(Yt + (size_t)c * TS + tile * 64 + h * 32 + i * 8); }
    __syncthreads();
#pragma unroll 2
    for (int rr = 0; rr < 8; ++rr) {
      const int rl = wv * 8 + rr, row = tile * 64 + rl;
      bf16_t* mr = MIX + (size_t)row * D + c4; const bf16_t* br = OB + (size_t)row * D + c4; const bf16_t* pr = P + (size_t)row * NP + c4;
      const u32x2 m0 = *(const u32x2*)mr, m2 = *(const u32x2*)(mr + 512), m3 = *(const u32x2*)(mr + 768);
      const u32x2 b0 = *(const u32x2*)br, b2 = *(const u32x2*)(br + 512), b3 = *(const u32x2*)(br + 768);
      const u32x2 g0 = *(const u32x2*)(pr + C_RG), g2 = *(const u32x2*)(pr + C_GZ), g3 = *(const u32x2*)(pr + C_SZ);
      float a[4], b[4], g[4], o[4];
      u32x2 r0, r1, r2, r3;
      { unpk4(m0, a); unpk4(b0, b); unpk4(g0, g); float ss = 0.f;
#pragma unroll
        for (int e = 0; e < 4; ++e) { o[e] = a[e] + b[e]; ss += o[e] * o[e]; }
        ss += __shfl_xor(ss, 1); ss += __shfl_xor(ss, 2); ss += __shfl_xor(ss, 4); ss += __shfl_xor(ss, 8);
        const float rstd = rsqrtf(ss * (1.f / 64.f) + EPS);
        r0.x = pk2(o[0] * rstd * w_ret.x * silu_f(g[0]), o[1] * rstd * w_ret.y * silu_f(g[1])); r0.y = pk2(o[2] * rstd * w_ret.z * silu_f(g[2]), o[3] * rstd * w_ret.w * silu_f(g[3])); }
      {
#pragma unroll
        for (int e = 0; e < 4; ++e) o[e] = bf2f(sY[(c4 + e) * 72 + rl]);
        const float ss = o[0] * o[0] + o[1] * o[1] + o[2] * o[2] + o[3] * o[3];
        const float rstd = rsqrtf(wave_sum(ss) * (1.f / 256.f) + EPS);
        r1.x = pk2(o[0] * rstd * w_hy.x, o[1] * rstd * w_hy.y); r1.y = pk2(o[2] * rstd * w_hy.z, o[3] * rstd * w_hy.w); }
      { unpk4(m2, a); unpk4(b2, b); unpk4(g2, g); float ss = 0.f;
#pragma unroll
        for (int e = 0; e < 4; ++e) { o[e] = a[e] + b[e]; ss += o[e] * o[e]; }
        ss += __shfl_xor(ss, 1); ss += __shfl_xor(ss, 2); ss += __shfl_xor(ss, 4); ss += __shfl_xor(ss, 8);
        const float rstd = rsqrtf(ss * (1.f / 64.f) + EPS);
        r2.x = pk2(o[0] * rstd * w_gdn.x * silu_f(g[0]), o[1] * rstd * w_gdn.y * silu_f(g[1])); r2.y = pk2(o[2] * rstd * w_gdn.z * silu_f(g[2]), o[3] * rstd * w_gdn.w * silu_f(g[3])); }
      { unpk4(m3, a); unpk4(b3, b); unpk4(g3, g); float ss = 0.f;
#pragma unroll
        for (int e = 0; e < 4; ++e) { o[e] = (a[e] + b[e]) * silu_f(g[e]); ss += o[e] * o[e]; }
        ss += __shfl_xor(ss, 1); ss += __shfl_xor(ss, 2); ss += __shfl_xor(ss, 4); ss += __shfl_xor(ss, 8); ss += __shfl_xor(ss, 16);
        const float rstd = rsqrtf(ss * (1.f / 128.f) + EPS);
        r3.x = pk2(o[0] * rstd * w_ssd.x, o[1] * rstd * w_ssd.y); r3.y = pk2(o[2] * rstd * w_ssd.z, o[3] * rstd * w_ssd.w); }
      *(u32x2*)mr = r0; *(u32x2*)(mr + 256) = r1; *(u32x2*)(mr + 512) = r2; *(u32x2*)(mr + 768) = r3;
    }
  }
}

__global__ void __launch_bounds__(512) fwd_mega(Params p) {
  cg::grid_group grid = cg::this_grid();
  extern __shared__ __attribute__((aligned(16))) unsigned char lds[];
  PG8_LAS unsigned char* ldsl = (PG8_LAS unsigned char*)lds;
  int* slot = (int*)lds;
#ifdef X_REP_ALL
  unsigned* ctr0 = (unsigned*)(p.ws + WS_CTR);
#else
  unsigned* ctr = (unsigned*)(p.ws + WS_CTR);
#endif
  const bf16_t* Hb = (const bf16_t*)(p.ws + WS_H);
  bf16_t* Pb = (bf16_t*)(p.ws + WS_P);
  float* Xb = (float*)(p.ws + WS_X);
  const float* mod = (const float*)(p.ws + WS_MOD);

  volatile XLAS unsigned* xst = (volatile XLAS unsigned*)(ldsl + 147456 - 16);
  if (threadIdx.x == 0) { xst[0] = 0u; xst[1] = 0u; }
  __syncthreads();
  phase0(p, lds + 64);
  grid.sync();
  const XcdBarrier xb = xcd_barrier_post((unsigned*)(p.ws + WS_BAR), xst);
#ifdef X_REP_XB
  for (int i = 0; i < 40; ++i) xcd_barrier(xb);
#endif
  for (int layer = 0; layer < NL; ++layer) {
#ifdef X_REP_ALL
    for (int rep = 0; rep < 2; ++rep) {
    unsigned* ctr = ctr0 + rep * 32;
#endif
    if (layer == 0) convert_weights(p, layer, lds + 64);
    norm_phase(p, layer, 0);
    xcd_barrier(xb);
    { pg8::Gemm g{Hb, (const bf16_t*)(p.ws + (size_t)(layer & 1) * WBUF + WS_WIN), T, NP, D}; pg8::StaticOrder S; S.init(T, NP, gridDim.x, blockIdx.x);
      EpiP E{Pb, (float*)(p.ws + WS_GATE)}; pg8::gemm_phase<EpiP, pg8::StaticOrder>(ldsl, g, S, E, nullptr); }
    xcd_barrier(xb);
    { unsigned* q = ctr + layer * 16;
      if (blockIdx.x < 96) {
        const int id = blockIdx.x;
        const int mixer = id >> 5, rem = id & 31, seq = 32 + (rem >> 3), head = (rem >> 1) & 3, dir = rem & 1;
        if (mixer == 0) gdn_task(p, layer, seq, head, dir, lds);
        if (mixer == 1) decay_task<true>(p, layer, seq, head, dir, lds);
        if (mixer == 2) decay_task<false>(p, layer, seq, head, dir, lds);
      }
      const int s0 = (blockIdx.x >> 4) % 5;
      for (int i = 0; i < 5; ++i) {
        const int ty = (s0 + i) % 5;
        const int cnt = ty == 4 ? (layer + 1 < NL ? CV_ALL / 8 : 0) : 256;
        for (;;) {
          const int id = next_task(q + 2 + ty, slot);
          if (id >= cnt) break;
          if (ty == 0) {
            hy1_task(p, layer, id, lds);
            __threadfence(); __syncthreads();
            if (threadIdx.x == 0) __hip_atomic_fetch_add(q + 1, 1u, __ATOMIC_RELEASE, __HIP_MEMORY_SCOPE_AGENT);
          } else if (ty == 4) {
            convert_item4(p, layer + 1, id * 8, (float*)(lds + 64)); convert_item4(p, layer + 1, id * 8 + 4, (float*)(lds + 64));
          } else {
            const int seq = id >> 3, head = (id >> 1) & 3, dir = id & 1;
            if (ty == 1) gdn_task(p, layer, seq, head, dir, lds);
            if (ty == 2) decay_task<true>(p, layer, seq, head, dir, lds);
            if (ty == 3) decay_task<false>(p, layer, seq, head, dir, lds);
          }
        }
      }
      if (threadIdx.x == 0) { while (__hip_atomic_load(q + 1, __ATOMIC_ACQUIRE, __HIP_MEMORY_SCOPE_AGENT) < 256u) __builtin_amdgcn_s_sleep(8); }
      __syncthreads(); __threadfence();
      for (;;) { const int id = next_task(q + 7, slot); if (id >= 256) break; hy2_task<true>(p, layer, id, lds); }
      for (;;) { const int id = next_task(q + 8, slot); if (id >= 256) break; hy2_task<false>(p, layer, id, lds); }
    }
    xcd_barrier(xb);
    finalize_rows(p, layer, lds);
    xcd_barrier(xb);
#ifdef X_REP_ALL
    }
#endif
    { pg8::Gemm g{(const bf16_t*)(p.ws + WS_MIX), (const bf16_t*)(p.ws + (size_t)(layer & 1) * WBUF + WS_WOUT), T, D, D}; pg8::StaticOrder S; S.init(T, D, gridDim.x, blockIdx.x);
      EpiRes E{layer == 0 ? p.x_prompt : Xb, layer == 0 ? p.x_sample : Xb + (size_t)TP * D, Xb, mod + (size_t)layer * 5 * 6144 + 2048};
      pg8::gemm_phase<EpiRes, pg8::StaticOrder>(ldsl, g, S, E, nullptr);
#if defined(X_REP_G24) || defined(X_REP_ALL)
      EpiRes E2 = E; E2.xout = (float*)(p.ws + WS_P); pg8::gemm_phase<EpiRes, pg8::StaticOrder>(ldsl, g, S, E2, nullptr);
#endif
    }
    xcd_barrier(xb);
#ifdef X_REP_ALL
    for (int rep2 = 0; rep2 < 2; ++rep2) {
#endif
    norm_phase(p, layer, 1);
    xcd_barrier(xb);
    { pg8::Gemm g{Hb, (const bf16_t*)(p.ws + (size_t)(layer & 1) * WBUF + WS_W1), T, 4096, D}; pg8::StaticOrder S; S.init(T, 4096, gridDim.x, blockIdx.x);
      EpiRelu2 E{Pb}; pg8::gemm_phase<EpiRelu2, pg8::StaticOrder>(ldsl, g, S, E, nullptr); }
    xcd_barrier(xb);
#ifdef X_REP_ALL
    }
#endif
    { pg8::Gemm g{Pb, (const bf16_t*)(p.ws + (size_t)(layer & 1) * WBUF + WS_W2), T, D, 4096}; pg8::StaticOrder S; S.init(T, D, gridDim.x, blockIdx.x);
      EpiRes E{Xb, Xb + (size_t)TP * D, Xb, mod + (size_t)layer * 5 * 6144 + 5120};
#if defined(X_REP_G24) || defined(X_REP_ALL)
      { EpiRes E2 = E; E2.xout = (float*)(p.ws + WS_MIX); pg8::gemm_phase<EpiRes, pg8::StaticOrder>(ldsl, g, S, E2, nullptr); }
#endif
      pg8::gemm_phase<EpiRes, pg8::StaticOrder>(ldsl, g, S, E, nullptr); }
    xcd_barrier(xb);
  }
  final_norm(p);
}

extern "C" void kernel_launch(void* const* d_in, const int* in_sizes, int n_in, void* d_out, int out_size,
                              void* d_ws, size_t ws_size, hipStream_t stream) {
  constexpr size_t kDynLds = 144 * 1024;
  static int grid_blocks = 0;
  if (!grid_blocks) {
    int dev = 0, cus = 0, per_cu = 0;
    (void)hipGetDevice(&dev);
    (void)hipDeviceGetAttribute(&cus, hipDeviceAttributeMultiprocessorCount, dev);
    (void)hipFuncSetAttribute((const void*)fwd_mega, hipFuncAttributeMaxDynamicSharedMemorySize, (int)kDynLds);
    (void)hipOccupancyMaxActiveBlocksPerMultiprocessor(&per_cu, (const void*)fwd_mega, 512, kDynLds);
    grid_blocks = cus > 0 ? cus : 256;
    if (n_in != 38 || ws_size < WS_END || out_size != 33554432) { fprintf(stderr, "kernel_launch: unexpected sizes n_in %d ws %zu out %d\n", n_in, ws_size, out_size); grid_blocks = -1; }
  }
  if (grid_blocks < 0) return;
  Params p{};
  const float** pp = (const float**)&p;
  for (int i = 0; i < 38; ++i) pp[i] = (const float*)d_in[i];
  p.out = (float*)d_out; p.ws = (unsigned char*)d_ws;
  void* args[] = {&p};
  hipError_t e = hipLaunchCooperativeKernel((const void*)fwd_mega, dim3(grid_blocks), dim3(512), args, kDynLds, stream);
  if (e != hipSuccess) fprintf(stderr, "cooperative launch failed: %s (grid %d)\n", hipGetErrorString(e), grid_blocks);
}
```

```cpp
#include <hip/hip_runtime.h>
#include <hip/hip_cooperative_groups.h>
#include <cstdio>
namespace cg = cooperative_groups;
namespace pg8 {
#define PG8_LAS __attribute__((address_space(3)))
typedef unsigned short bf16_t;
typedef short bf16x8 __attribute__((ext_vector_type(8)));
typedef float f32x4 __attribute__((ext_vector_type(4)));
typedef unsigned u32x4 __attribute__((ext_vector_type(4)));
constexpr int BM = 256, BK = 64, HALF = 128, HTB = HALF * BK * 2  , STAGE_BYTES = 8 * HTB, NXCD = 8, WGM = 8;

__host__ __device__ __forceinline__ int lds_byte(int r, int c) { const int st = (r >> 4) * 2 + (c >> 5), rr = r & 15, cc = c & 31, ob = rr * 64 + cc * 2; return st * 1024 + (ob ^ (((ob >> 9) & 1) << 5)); }
__host__ __device__ __forceinline__ void stage_rc(int b, int& R, int& C) { const int st = b / 1024, sb = b % 1024, swz = sb ^ (((sb >> 9) & 1) << 5); R = (st >> 1) * 16 + swz / 64; C = (st & 1) * 32 + (swz % 64) / 2; }
__host__ __device__ __forceinline__ int perm32(int rho) { const int n = rho >> 4, i = rho & 15; return 8 * (i >> 2) + 4 * n + (i & 3); }

struct Unit { int pm, pn; };
struct Gemm { const bf16_t* A; const bf16_t* Bt; int M, N, K; };

struct StaticOrder {
    int nM, nN, nwg, G, c;
    __host__ __device__ void init(int M, int N, int G_, int c_) { nM = M / BM; nN = N / BM; nwg = nM * nN; G = G_; c = c_; }
    __host__ __device__ bool next(int i, Unit& u) const {
        const long L = (long)i * G + c; if (L >= nwg) return false;
        int wgid = (int)L; { const int q = nwg / NXCD, r = nwg % NXCD, xcd = wgid % NXCD, off = wgid / NXCD; wgid = (xcd < r ? xcd * (q + 1) : r * (q + 1) + (xcd - r) * q) + off; }
        const int nig = WGM * nN, gid = wgid / nig, fm = gid * WGM, gsz = (nM - fm) < WGM ? (nM - fm) : WGM;
        u.pm = fm + ((wgid % nig) % gsz); u.pn = (wgid % nig) / gsz; return true;
    }
    __device__ __forceinline__ void a_ready(const Unit&) const {}
    __device__ __forceinline__ void done(const Unit&) const {}
};
__device__ __forceinline__ unsigned cvt_pk_bf16(float lo, float hi) { unsigned r; asm volatile("v_cvt_pk_bf16_f32 %0, %1, %2" : "=v"(r) : "v"(lo), "v"(hi)); return r; }

template <class Epi, class Sched, bool STAMP = false>
__device__ __forceinline__ void gemm_phase(PG8_LAS unsigned char* lds, const Gemm g, const Sched& S, const Epi& E, unsigned long long* stamps) {
    int tid_l = threadIdx.x; asm volatile("" : "+v"(tid_l));
    const int tid = tid_l, wid = __builtin_amdgcn_readfirstlane(tid >> 6), lane = tid & 63, wr = wid >> 2, wc = wid & 3, fr = lane & 15, fq = lane >> 4;
    const int K = g.K, nt = K / BK;
    int ts_lo = 0, ts_hi = 0, nts = 0; const unsigned long long rt_entry = STAMP ? (unsigned long long)wall_clock64() : 0ull;
#define PG8_STAMP() do { if (STAMP && wid == 0 && nts < 64) { const unsigned long long _c = (unsigned long long)clock64(); \
        ts_lo = (lane == nts) ? (int)(unsigned)_c : ts_lo; ts_hi = (lane == nts) ? (int)(unsigned)(_c >> 32) : ts_hi; ++nts; } } while (0)
    PG8_STAMP();
    unsigned voffA[2], voffB[2];
#pragma unroll
    for (int i = 0; i < 2; ++i) { int R, C; stage_rc(tid * 16 + i * 8192, R, C); const int Rb = Epi::PERM ? ((R & ~31) + perm32(R & 31)) : R;
        voffA[i] = (unsigned)(R * K + C) * 2u; voffB[i] = (unsigned)(Rb * K + C) * 2u; }
    const size_t kstep = (size_t)(BK * 2);
    const size_t hstep = (size_t)HALF * K * 2;
    const size_t tstep = 2 * hstep;
    const unsigned ldsw = (unsigned)wid * 1024u;
    const int aoff = lds_byte(wr * 64 + fr, fq * 8), boff = lds_byte(wc * 32 + fr, fq * 8);
#define PG8_SA(b, h) (((b) * 2 + (h)) * HTB)
#define PG8_SB(b, h) ((4 + (b) * 2 + (h)) * HTB)
#define PG8_STAGE(bufoff, gbase, voff) do { _Pragma("unroll") for (int _i = 0; _i < 2; ++_i) \
        __builtin_amdgcn_global_load_lds((const unsigned*)((const char*)(gbase) + (voff)[_i]), (PG8_LAS unsigned*)(lds + (bufoff) + ldsw + _i * 8192), 16, 0, 0); } while (0)
#define PG8_LDA(dst, b, h) do { _Pragma("unroll") for (int m = 0; m < 4; ++m) _Pragma("unroll") for (int k = 0; k < 2; ++k) dst[m][k] = *(const PG8_LAS bf16x8*)(lds + PG8_SA(b, h) + aoff + m * 2048 + k * 1024); } while (0)
#define PG8_LDB(dst, b, h) do { _Pragma("unroll") for (int n = 0; n < 2; ++n) _Pragma("unroll") for (int k = 0; k < 2; ++k) dst[n][k] = *(const PG8_LAS bf16x8*)(lds + PG8_SB(b, h) + boff + n * 2048 + k * 1024); } while (0)
#define PG8_MMA(ai, bj, At, Bt) do { __builtin_amdgcn_s_setprio(1); _Pragma("unroll") for (int m = 0; m < 4; ++m) _Pragma("unroll") for (int n = 0; n < 2; ++n) _Pragma("unroll") for (int k = 0; k < 2; ++k) \
        acc[ai][bj][m][n] = __builtin_amdgcn_mfma_f32_16x16x32_bf16(Bt[n][k], At[m][k], acc[ai][bj][m][n], 0, 0, 0); __builtin_amdgcn_s_setprio(0); } while (0)
#define PG8_WAIT_V(n) asm volatile("s_waitcnt vmcnt(" #n ")" ::: "memory")
#define PG8_WAIT_L(n) asm volatile("s_waitcnt lgkmcnt(" #n ")" ::: "memory")
#define PG8_BAR __builtin_amdgcn_s_barrier()
#define PG8_SCHED __builtin_amdgcn_sched_barrier(0)
    Unit cur, nxt; int ui = 0;
    if (!S.next(0, cur)) return;
    f32x4 acc[2][2][4][2];
#pragma unroll
    for (int a = 0; a < 2; ++a)
#pragma unroll
        for (int b = 0; b < 2; ++b)
#pragma unroll
            for (int m = 0; m < 4; ++m)
#pragma unroll
                for (int n = 0; n < 2; ++n) acc[a][b][m][n] = (f32x4){0.f, 0.f, 0.f, 0.f};
    bf16x8 At[4][2], B0[2][2], B1[2][2];
    const char* cA = (const char*)g.A + (size_t)cur.pm * tstep; const char* cB = (const char*)g.Bt + (size_t)cur.pn * tstep;
    S.a_ready(cur);
    PG8_STAGE(PG8_SB(0, 0), cB, voffB); PG8_STAGE(PG8_SA(0, 0), cA, voffA); PG8_STAGE(PG8_SB(0, 1), cB + hstep, voffB); PG8_STAGE(PG8_SA(0, 1), cA + hstep, voffA);
    if (wr == 1) PG8_BAR;
    PG8_WAIT_V(4); PG8_BAR;
    PG8_STAGE(PG8_SB(1, 0), cB + kstep, voffB); PG8_STAGE(PG8_SA(1, 0), cA + kstep, voffA); PG8_STAGE(PG8_SB(1, 1), cB + hstep + kstep, voffB);
    PG8_WAIT_V(6); PG8_BAR;
    PG8_STAMP();
    for (;;) {
        const bool has_next = S.next(ui + 1, nxt);
        const char* nA = has_next ? (const char*)g.A + (size_t)nxt.pm * tstep : cA; const char* nB = has_next ? (const char*)g.Bt + (size_t)nxt.pn * tstep : cB;
        for (int t = 0; t < nt; t += 2) {
            const bool last = (t == nt - 2);
            const char* a1 = cA + (size_t)(t + 1) * kstep;
            const char* a2 = last ? nA : cA + (size_t)(t + 2) * kstep; const char* b2 = last ? nB : cB + (size_t)(t + 2) * kstep;
            const char* a3 = a2 + kstep; const char* b3 = b2 + kstep;
            if (last && has_next) S.a_ready(nxt);
            PG8_LDB(B0, 0, 0); PG8_SCHED; PG8_LDA(At, 0, 0); PG8_STAGE(PG8_SA(1, 1), a1 + hstep, voffA);
            PG8_WAIT_L(8); PG8_BAR; PG8_WAIT_L(0); PG8_MMA(0, 0, At, B0); PG8_BAR; PG8_SCHED;
            PG8_LDB(B1, 0, 1); PG8_STAGE(PG8_SB(0, 0), b2, voffB);
            PG8_BAR; PG8_WAIT_L(0); PG8_MMA(0, 1, At, B1); PG8_BAR;
            PG8_LDA(At, 0, 1); PG8_STAGE(PG8_SA(0, 0), a2, voffA);
            PG8_BAR; PG8_WAIT_L(0); PG8_MMA(1, 0, At, B0); PG8_BAR; PG8_SCHED;
            PG8_STAGE(PG8_SB(0, 1), b2 + hstep, voffB);
            PG8_WAIT_V(6); PG8_BAR; PG8_MMA(1, 1, At, B1); PG8_BAR;
            PG8_LDB(B0, 1, 0); PG8_SCHED; PG8_LDA(At, 1, 0); PG8_STAGE(PG8_SA(0, 1), a2 + hstep, voffA);
            PG8_WAIT_L(8); PG8_BAR; PG8_WAIT_L(0); PG8_MMA(0, 0, At, B0); PG8_BAR; PG8_SCHED;
            PG8_LDB(B1, 1, 1); PG8_STAGE(PG8_SB(1, 0), b3, voffB);
            PG8_BAR; PG8_WAIT_L(0); PG8_MMA(0, 1, At, B1); PG8_BAR;
            PG8_LDA(At, 1, 1); PG8_STAGE(PG8_SA(1, 0), a3, voffA);
            PG8_BAR; PG8_WAIT_L(0); PG8_MMA(1, 0, At, B0); PG8_BAR; PG8_SCHED;
            PG8_STAGE(PG8_SB(1, 1), b3 + hstep, voffB);
            PG8_WAIT_V(6); PG8_BAR; PG8_MMA(1, 1, At, B1); PG8_BAR;
        }
        PG8_STAMP();
        if constexpr (!Epi::AFTER_DRAIN) { E(acc, cur, wr, wc, fr, fq); S.done(cur); }
        PG8_STAMP();
        if (!has_next) break;
#pragma unroll
        for (int a = 0; a < 2; ++a)
#pragma unroll
            for (int b = 0; b < 2; ++b)
#pragma unroll
                for (int m = 0; m < 4; ++m)
#pragma unroll
                    for (int n = 0; n < 2; ++n) acc[a][b][m][n] = (f32x4){0.f, 0.f, 0.f, 0.f};
        cur = nxt; cA = nA; cB = nB; ++ui;
    }
    PG8_WAIT_V(0);
    if (wr == 0) PG8_BAR;
    PG8_BAR;
    if constexpr (Epi::AFTER_DRAIN) { E.fused(acc, cur, wr, wc, fr, fq, lds, wid, lane); S.done(cur); }
    PG8_STAMP();
    if (STAMP && wid == 0) { stamps[lane] = lane < nts ? (((unsigned long long)(unsigned)ts_hi << 32) | (unsigned)ts_lo) : 0ull;
        if (lane == 62) stamps[62] = rt_entry; if (lane == 63) stamps[63] = (unsigned long long)wall_clock64(); }
#undef PG8_STAMP
#undef PG8_SA
#undef PG8_SB
#undef PG8_STAGE
#undef PG8_LDA
#undef PG8_LDB
#undef PG8_MMA
#undef PG8_WAIT_V
#undef PG8_WAIT_L
#undef PG8_BAR
#undef PG8_SCHED
}
}
#define XB_TMO      128
#define XB_XCNT(j)  (256  + 64 * (j))
#define XB_XSUB(j)  (1280 + 64 * (j))
#define XB_XGEN(j)  (2304 + 64 * (j))
#define XB_TOP      3328
#define XB_TOPGEN   3392
#define XCD_BAR_WORDS 3456
#define XB_SPIN_CAP (1u << 22)
#define XLAS __attribute__((address_space(3)))

__device__ __forceinline__ unsigned xb_ld(unsigned* p)              { return __hip_atomic_load(p, __ATOMIC_RELAXED, __HIP_MEMORY_SCOPE_AGENT); }
__device__ __forceinline__ unsigned xb_add(unsigned* p, unsigned v) { return __hip_atomic_fetch_add(p, v, __ATOMIC_RELAXED, __HIP_MEMORY_SCOPE_AGENT); }
__device__ __forceinline__ unsigned xb_xcc_id() { return (unsigned)__builtin_amdgcn_s_getreg((3 << 11) | 20) & 0xFu; }
#define XB_SPIN(cond, bar) do { unsigned _sp = 0; while (cond) { __builtin_amdgcn_s_sleep(1); \
    if ((++_sp & 255u) == 0u) { if (xb_ld(&(bar)[XB_TMO])) break; if (_sp > XB_SPIN_CAP) { atomicAdd(&(bar)[XB_TMO], 1u); break; } } } } while (0)

struct XcdBarrier {
    unsigned* bar; unsigned x;
    volatile XLAS unsigned* st;
};

__device__ __forceinline__ XcdBarrier xcd_barrier_post(unsigned* bar, volatile XLAS unsigned* st) {
    XcdBarrier b; b.bar = bar; b.x = xb_xcc_id(); b.st = st;
    if (threadIdx.x == 0) (void)xb_add(&bar[XB_XCNT(b.x)], 1u);
    return b;
}
__device__ __forceinline__ void xcd_barrier_complete(unsigned* bar, unsigned x, unsigned& nloc, unsigned& nx) {
    const unsigned G = gridDim.x * gridDim.y * gridDim.z;
    unsigned sum, cnt, mine, sp = 0u;
    for (;;) {
        sum = 0u; cnt = 0u; mine = 0u;
#pragma unroll
        for (unsigned j = 0; j < 16; ++j) { const unsigned c = xb_ld(&bar[XB_XCNT(j)]); sum += c; cnt += (c > 0u) ? 1u : 0u; mine = (j == x) ? c : mine; }
        if (sum == G) break;
        __builtin_amdgcn_s_sleep(1);
        if ((++sp & 255u) == 0u) { if (xb_ld(&bar[XB_TMO])) break; if (sp > XB_SPIN_CAP) { atomicAdd(&bar[XB_TMO], 1u); break; } }
    }
    nloc = mine > 0u ? mine : 1u; nx = cnt > 0u ? cnt : 1u;
}

__device__ __forceinline__ void xcd_barrier(const XcdBarrier& b) {
    asm volatile("s_waitcnt vmcnt(0)" ::: "memory");
    __syncthreads();
    if (threadIdx.x == 0) {
        unsigned* bar = b.bar;
        __builtin_amdgcn_s_waitcnt(0);
        unsigned nloc = b.st[0], nx = b.st[1];
        if (nloc == 0u) { xcd_barrier_complete(bar, b.x, nloc, nx); b.st[0] = nloc; b.st[1] = nx; }
        const unsigned old = xb_add(&bar[XB_XSUB(b.x)], 1u);
        const unsigned gen = old / nloc;
        if (old + 1u == (gen + 1u) * nloc) {
            __builtin_amdgcn_fence(__ATOMIC_RELEASE, "agent");
            asm volatile("s_waitcnt vmcnt(0)" ::: "memory");
            const unsigned og = xb_add(&bar[XB_TOP], 1u);
            const unsigned tg = og / nx;
            if (og + 1u == (tg + 1u) * nx) xb_add(&bar[XB_TOPGEN], 1u);
            else XB_SPIN(xb_ld(&bar[XB_TOPGEN]) == tg, bar);
            __builtin_amdgcn_fence(__ATOMIC_ACQUIRE, "agent");
            xb_add(&bar[XB_XGEN(b.x)], 1u);
            asm volatile("s_waitcnt vmcnt(0)" ::: "memory");
        } else {
            XB_SPIN(xb_ld(&bar[XB_XGEN(b.x)]) == gen, bar);
            __builtin_amdgcn_fence(__ATOMIC_ACQUIRE, "agent");
            asm volatile("s_waitcnt vmcnt(0)" ::: "memory");
        }
    }
    __syncthreads();
}


using pg8::bf16_t; using pg8::bf16x8; using pg8::f32x4; using pg8::u32x4;
typedef float f32x2v __attribute__((ext_vector_type(2)));
typedef unsigned u32x2 __attribute__((ext_vector_type(2)));

constexpr int T = 16384, TP = 8192, D = 1024, NP = 4096, NL = 4;
constexpr float EPS = 1e-6f;
constexpr int C_RQ = 0, C_RK = 256, C_RV = 512, C_RG = 768, C_HY = 1024;
constexpr int C_GQ = 1792, C_GK = 2048, C_GV = 2304, C_GZ = 2560;
constexpr int C_SX = 2832, C_SB = 3088, C_SC = 3344, C_SZ = 3600;
constexpr int INC = 3864;

constexpr size_t WS_CTR = 0;
constexpr size_t WS_BAR = 4096;
constexpr size_t WS_MOD = 4096 + 16384;
constexpr size_t WS_GATE = WS_MOD + 491520;
constexpr size_t WS_X = WS_GATE + (size_t)T * 32 * 4;
constexpr size_t WS_H = WS_X + (size_t)T * D * 4;
constexpr size_t WS_P = WS_H + (size_t)T * D * 2;
constexpr size_t WS_MIX = WS_P + (size_t)T * NP * 2;
constexpr size_t WS_OB = WS_MIX + (size_t)T * D * 2;
constexpr size_t WS_WIN = WS_OB + (size_t)T * D * 2;
constexpr size_t WS_WOUT = WS_WIN + 8388608;
constexpr size_t WS_W1 = WS_WOUT + 2097152;
constexpr size_t WS_W2 = WS_W1 + 8388608;
constexpr size_t WBUF = 27262976;
constexpr size_t WS_TAPS = WS_W2 + 8388608 + WBUF;
constexpr int GT_CH = 4640, GT_SOFF = 528;
constexpr int TS = T + 64;
constexpr size_t WS_U = WS_TAPS + (size_t)4 * 256 * GT_CH * 2;
constexpr size_t WS_X0 = WS_U + (size_t)TS * 256 * 2;
constexpr size_t WS_Y = WS_X0 + (size_t)TS * 256 * 2;
constexpr size_t WS_END = WS_Y + (size_t)TS * 256 * 2;

constexpr size_t OUT_RET = (size_t)T * D, OUT_GDN = OUT_RET + 4194304, OUT_SSD = OUT_GDN + 4194304;

struct Params {
  const float *x_prompt, *x_sample, *state_ret, *state_gdn, *state_ssd, *c, *c_ctx;
  const float *norm1_w, *norm2_w, *w_mod, *b_mod, *w_in, *w_out, *ret_log_decay, *ret_norm_w;
  const float *hy_conv_w, *hy_conv_b, *hy_freq, *hy_w1, *hy_b1, *hy_w2, *hy_b2, *hy_w3, *hy_bias, *hy_norm_w;
  const float *gdn_conv_w, *gdn_A_log, *gdn_dt_bias, *gdn_norm_w;
  const float *ssd_conv_w, *ssd_conv_b, *ssd_A_log, *ssd_dt_bias, *ssd_D, *ssd_norm_w;
  const float *mlp_w1, *mlp_w2, *final_norm_w;
  float* out; unsigned char* ws;
};

__device__ __forceinline__ float wave_sum(float v) {
#pragma unroll
  for (int o = 32; o >= 1; o >>= 1) v += __shfl_xor(v, o);
  return v;
}
__device__ __forceinline__ bf16_t f2bf(float f) { return __builtin_bit_cast(unsigned short, (__bf16)f); }
__device__ __forceinline__ float bf2f(bf16_t b) { return __uint_as_float(((unsigned)b) << 16); }
__device__ __forceinline__ unsigned pk2(float lo, float hi) { return pg8::cvt_pk_bf16(lo, hi); }
__device__ __forceinline__ float silu_f(float x) { return x * __builtin_amdgcn_rcpf(1.f + __expf(-x)); }
__device__ __forceinline__ float sigmoid_f(float x) { return __builtin_amdgcn_rcpf(1.f + __expf(-x)); }
__device__ __forceinline__ float softplus_f(float x) {
  if (x > 20.f) return x;
  const float e = __expf(x);
  return e < 0.01f ? e * (1.f - e * (0.5f - e * 0.33333334f)) : __logf(1.f + e);
}
__device__ __forceinline__ void ld8(const bf16_t* p, float (&o)[8]) {
  const u32x4 v = *(const u32x4*)p;
  o[0] = __uint_as_float(v.x << 16); o[1] = __uint_as_float(v.x & 0xffff0000u);
  o[2] = __uint_as_float(v.y << 16); o[3] = __uint_as_float(v.y & 0xffff0000u);
  o[4] = __uint_as_float(v.z << 16); o[5] = __uint_as_float(v.z & 0xffff0000u);
  o[6] = __uint_as_float(v.w << 16); o[7] = __uint_as_float(v.w & 0xffff0000u);
}
__device__ __forceinline__ void ldf8(const float* p, float (&o)[8]) {
  const f32x4 a = *(const f32x4*)p, b = *(const f32x4*)(p + 4);
  o[0] = a.x; o[1] = a.y; o[2] = a.z; o[3] = a.w; o[4] = b.x; o[5] = b.y; o[6] = b.z; o[7] = b.w;
}
__device__ __forceinline__ void st8bf(bf16_t* p, const float (&v)[8]) {
  u32x4 w; w.x = pk2(v[0], v[1]); w.y = pk2(v[2], v[3]); w.z = pk2(v[4], v[5]); w.w = pk2(v[6], v[7]);
  *(u32x4*)p = w;
}
__device__ __forceinline__ void conv8(const bf16_t* prow, int t, int L, const float* cw, const float* cb, float (&o)[8]) {
  float x[8], w[8];
  ld8(prow, x); ldf8(cw + 768, w);
  if (cb) { float b[8]; ldf8(cb, b);
#pragma unroll
    for (int e = 0; e < 8; ++e) o[e] = x[e] * w[e] + b[e];
  } else {
#pragma unroll
    for (int e = 0; e < 8; ++e) o[e] = x[e] * w[e];
  }
  if (t > 0) { ld8(prow - NP, x); ldf8(cw, w);
#pragma unroll
    for (int e = 0; e < 8; ++e) o[e] += x[e] * w[e]; }
  if (t < L - 1) { ld8(prow + NP, x); ldf8(cw + 1536, w);
#pragma unroll
    for (int e = 0; e < 8; ++e) o[e] += x[e] * w[e]; }
}
__device__ __forceinline__ void ld8v(u32x4 v, float (&o)[8]) {
  o[0] = __uint_as_float(v.x << 16); o[1] = __uint_as_float(v.x & 0xffff0000u); o[2] = __uint_as_float(v.y << 16); o[3] = __uint_as_float(v.y & 0xffff0000u);
  o[4] = __uint_as_float(v.z << 16); o[5] = __uint_as_float(v.z & 0xffff0000u); o[6] = __uint_as_float(v.w << 16); o[7] = __uint_as_float(v.w & 0xffff0000u); }
__device__ __forceinline__ void conv8b(const bf16_t* prow, int t, int L, const float* cw, const float* cb, float (&o)[8]) {
  const int dm = t > 0 ? -NP : 0, dp = t < L - 1 ? NP : 0;
  const float m0 = t > 0 ? 1.f : 0.f, m2 = t < L - 1 ? 1.f : 0.f;
  const u32x4 r0 = *(const u32x4*)(prow + dm), r1 = *(const u32x4*)prow, r2 = *(const u32x4*)(prow + dp);
  float x0[8], x1[8], x2[8], w0[8], w1[8], w2[8], b[8];
  ldf8(cw, w0); ldf8(cw + 768, w1); ldf8(cw + 1536, w2); ldf8(cb, b);
  ld8v(r0, x0); ld8v(r1, x1); ld8v(r2, x2);
#pragma unroll
  for (int e = 0; e < 8; ++e) o[e] = b[e] + x1[e] * w1[e] + m0 * (x0[e] * w0[e]) + m2 * (x2[e] * w2[e]);
}
__device__ __forceinline__ f32x4 mma_tile(const bf16_t* A, int lda, const bf16_t* Bt, int ldb, int K, f32x4 acc, int lane, int xa = 0, int xb = 0) {
  const bf16_t* ap = A + (lane & 15) * lda;
  const bf16_t* bp = Bt + (lane & 15) * ldb;
  const int kq = (lane >> 4) * 8;
  for (int k0 = 0; k0 < K; k0 += 32) {
    const bf16x8 a = *(const bf16x8*)(ap + ((k0 + kq) ^ xa)), b = *(const bf16x8*)(bp + ((k0 + kq) ^ xb));
    acc = __builtin_amdgcn_mfma_f32_16x16x32_bf16(a, b, acc, 0, 0, 0);
  }
  return acc;
}
__device__ __forceinline__ int next_task(unsigned* ctr, int* slot) {
  __syncthreads();
  if (threadIdx.x == 0) *slot = (int)atomicAdd(ctr, 1u);
  __syncthreads();
  return *(volatile int*)slot;
}
__device__ __forceinline__ const float* xrow_ptr(const Params& p, int layer, int row) {
  if (layer == 0) return row < TP ? p.x_prompt + (size_t)row * D : p.x_sample + (size_t)(row - TP) * D;
  return (const float*)(p.ws + WS_X) + (size_t)row * D;
}
__device__ __forceinline__ int cond_row(int row) { return row < TP ? 0 : 1 + ((row - TP) >> 11); }

struct EpiP {
  static constexpr bool PERM = true, AFTER_DRAIN = false;
  bf16_t* O; float* gates;
  __device__ __forceinline__ void operator()(const f32x4 (&acc)[2][2][4][2], const pg8::Unit& u, int wr, int wc, int fr, int fq) const {
    const int row0 = u.pm * 256 + wr * 64 + fr, col0 = u.pn * 256 + wc * 32 + 8 * fq;
#pragma unroll
    for (int ai = 0; ai < 2; ++ai)
#pragma unroll
      for (int m = 0; m < 4; ++m) {
        const int row = row0 + ai * 128 + m * 16;
#pragma unroll
        for (int bj = 0; bj < 2; ++bj) {
          const int col = col0 + bj * 128;
          const f32x4 v0 = acc[ai][bj][m][0], v1 = acc[ai][bj][m][1];
          u32x4 w; w.x = pk2(v0[0], v0[1]); w.y = pk2(v0[2], v0[3]); w.z = pk2(v1[0], v1[1]); w.w = pk2(v1[2], v1[3]);
          *(u32x4*)(O + (size_t)row * NP + col) = w;
          if (col >= 2816 && col < 2832) { float* g = gates + (size_t)row * 32 + (col - 2816); *(f32x4*)g = v0; *(f32x4*)(g + 4) = v1; }
          if (col == 3856) { float* g = gates + (size_t)row * 32 + 16; *(f32x4*)g = v0; *(f32x4*)(g + 4) = v1; }
        }
      }
  }
};
struct EpiRelu2 {
  static constexpr bool PERM = true, AFTER_DRAIN = false;
  bf16_t* O;
  __device__ __forceinline__ void operator()(const f32x4 (&acc)[2][2][4][2], const pg8::Unit& u, int wr, int wc, int fr, int fq) const {
    const int row0 = u.pm * 256 + wr * 64 + fr, col0 = u.pn * 256 + wc * 32 + 8 * fq;
#pragma unroll
    for (int ai = 0; ai < 2; ++ai)
#pragma unroll
      for (int m = 0; m < 4; ++m) {
        const int row = row0 + ai * 128 + m * 16;
#pragma unroll
        for (int bj = 0; bj < 2; ++bj) {
          const int col = col0 + bj * 128;
          f32x4 v0 = acc[ai][bj][m][0], v1 = acc[ai][bj][m][1];
#pragma unroll
          for (int j = 0; j < 4; ++j) { const float a = fmaxf(v0[j], 0.f), b = fmaxf(v1[j], 0.f); v0[j] = a * a; v1[j] = b * b; }
          u32x4 w; w.x = pk2(v0[0], v0[1]); w.y = pk2(v0[2], v0[3]); w.z = pk2(v1[0], v1[1]); w.w = pk2(v1[2], v1[3]);
          *(u32x4*)(O + (size_t)row * NP + col) = w;
        }
      }
  }
};
struct EpiRes {
  static constexpr bool PERM = false, AFTER_DRAIN = false;
  const float* xin_p; const float* xin_s; float* xout; const float* gate;
  __device__ __forceinline__ void operator()(const f32x4 (&acc)[2][2][4][2], const pg8::Unit& u, int wr, int wc, int fr, int fq) const {
    const int row0 = u.pm * 256 + wr * 64 + fr, col0 = u.pn * 256 + wc * 32 + 4 * fq;
    const float* gr = gate + (size_t)cond_row(u.pm * 256) * 6144 + col0;
    const float* xi0 = (u.pm * 256 < TP ? xin_p + (size_t)row0 * D : xin_s + (size_t)(row0 - TP) * D) + col0;
    float* xo0 = xout + (size_t)row0 * D + col0;
    f32x4 gv[2][2];
#pragma unroll
    for (int bj = 0; bj < 2; ++bj)
#pragma unroll
      for (int n = 0; n < 2; ++n) gv[bj][n] = *(const f32x4*)(gr + bj * 128 + n * 16);
    f32x4 xv[2][2][2];
#pragma unroll
    for (int bj = 0; bj < 2; ++bj)
#pragma unroll
      for (int n = 0; n < 2; ++n) xv[0][bj][n] = *(const f32x4*)(xi0 + bj * 128 + n * 16);
#pragma unroll
    for (int s = 0; s < 8; ++s) {
      const int ai = s >> 2, mm = s & 3;
      if (s < 7) { const int s1 = s + 1; const size_t off1 = (size_t)((s1 >> 2) * 128 + (s1 & 3) * 16) * D;
#pragma unroll
        for (int bj = 0; bj < 2; ++bj)
#pragma unroll
          for (int n = 0; n < 2; ++n) xv[(s + 1) & 1][bj][n] = *(const f32x4*)(xi0 + off1 + bj * 128 + n * 16); }
      const size_t off = (size_t)(ai * 128 + mm * 16) * D;
#pragma unroll
      for (int bj = 0; bj < 2; ++bj)
#pragma unroll
        for (int n = 0; n < 2; ++n) *(f32x4*)(xo0 + off + bj * 128 + n * 16) = xv[s & 1][bj][n] + gv[bj][n] * acc[ai][bj][mm][n];
    }
  }
};

__device__ __forceinline__ void phase0(const Params& p, unsigned char* lds) {
  int tid_l = threadIdx.x; asm volatile("" : "+v"(tid_l));
  const int tid = tid_l;
  float* mod = (float*)(p.ws + WS_MOD);
  if (blockIdx.x == 0) { if (tid < 64) ((unsigned*)(p.ws + WS_CTR))[tid] = 0u; for (int i = tid; i < XCD_BAR_WORDS; i += 512) ((unsigned*)(p.ws + WS_BAR))[i] = 0u; }
  float* sF = (float*)lds;
  constexpr int NMOD = NL * 48, NTAP = NL * 288;
  for (int task = blockIdx.x; task < NMOD + NTAP; task += gridDim.x) {
    __syncthreads();
    if (task < NMOD) {
      const int l = task / 48, cb = task % 48;
      float* sC = sF;
      float* sR = sF + 5120;
      for (int i = tid; i < 5120; i += 512) { const int r = i >> 10, k = i & 1023; const float v = (r == 0) ? p.c_ctx[k] : p.c[(r - 1) * 1024 + k]; sC[i] = silu_f(v); }
      __syncthreads();
      const int col = cb * 128 + (tid & 127), kq = tid >> 7;
      float a0 = 0.f, a1 = 0.f, a2 = 0.f, a3 = 0.f, a4 = 0.f;
      const float* wp = p.w_mod + ((size_t)l * 1024 + kq * 256) * 6144 + col;
#pragma unroll 8
      for (int k = 0; k < 256; ++k) {
        const float w = wp[(size_t)k * 6144]; const int kk = kq * 256 + k;
        a0 += sC[kk] * w; a1 += sC[1024 + kk] * w; a2 += sC[2048 + kk] * w; a3 += sC[3072 + kk] * w; a4 += sC[4096 + kk] * w;
      }
      float* rr = sR + kq * 640 + (tid & 127);
      rr[0] = a0; rr[128] = a1; rr[256] = a2; rr[384] = a3; rr[512] = a4;
      __syncthreads();
      if (tid < 128) {
        const float b = p.b_mod[l * 6144 + col];
#pragma unroll
        for (int r = 0; r < 5; ++r) mod[((size_t)l * 5 + r) * 6144 + col] = sR[r * 128 + tid] + sR[640 + r * 128 + tid] + sR[1280 + r * 128 + tid] + sR[1920 + r * 128 + tid] + b;
      }
    } else {
      const int tt = task - NMOD, l = tt / 288, g = tt % 288;
      const int L = g < 32 ? 256 : 2048, i0 = g < 32 ? g * 8 : (g - 32) * 8;
      float* sZ = sF;
      float* sH1 = sF + 288;
      float* sH2 = sF + 288 + 512;
      const int r8 = tid >> 6, j = tid & 63, i = i0 + r8;
      const float tn = (float)i / (float)(L - 1);
      if (j < 33) {
        float z;
        if (j == 0) z = tn;
        else {
          const int b = (j - 1) & 15;
          const float f = 1e-4f + (float)b * ((15.0f - 1e-4f) / 15.0f);
          const float wang = 6.283185307179586f * (float)i / (float)L;
          z = (j <= 16) ? cosf(f * wang) : -sinf(f * wang);
        }
        sZ[r8 * 36 + j] = z;
      }
      __syncthreads();
      const float fr = p.hy_freq[l * 64 + j];
      { float a = p.hy_b1[l * 64 + j];
        for (int e = 0; e < 33; ++e) a += sZ[r8 * 36 + e] * p.hy_w1[(l * 33 + e) * 64 + j];
        sH1[r8 * 64 + j] = sinf(fr * a); }
      __syncthreads();
      { float a = p.hy_b2[l * 64 + j];
        for (int e = 0; e < 64; ++e) a += sH1[r8 * 64 + e] * p.hy_w2[(l * 64 + e) * 64 + j];
        sH2[r8 * 64 + j] = sinf(fr * a); }
      __syncthreads();
      float acc[8];
#pragma unroll
      for (int r = 0; r < 8; ++r) acc[r] = 0.f;
      for (int e = 0; e < 64; ++e) {
        const float w = p.hy_w3[(l * 64 + e) * 512 + tid];
#pragma unroll
        for (int r = 0; r < 8; ++r) acc[r] += sH2[r * 64 + e] * w;
      }
      const int dir = tid >> 8, c = tid & 255;
      const float delta = 3.0701134573253944f + (float)c * ((15.350567286626973f - 3.0701134573253944f) / 255.0f);
      bf16_t* Gc = (bf16_t*)(p.ws + WS_TAPS) + ((size_t)l * 256 + c) * GT_CH + (L == 256 ? 0 : GT_SOFF);
#pragma unroll
      for (int r = 0; r < 8; ++r) {
        const int ii = i0 + r; const float tnr = (float)ii / (float)(L - 1);
        const float v = acc[r] * expf(-tnr * delta);
        if (dir == 0) Gc[L - ii] = f2bf(v);
        else if (ii >= 1) Gc[L + ii] = f2bf(v);
      }
    }
  }
}

constexpr int CV_IN = 16 * 64, CV_OUT = 16 * 16, CV_1 = 16 * 64, CV_2 = 64 * 16, CV_ALL = CV_IN + CV_OUT + CV_1 + CV_2;
__device__ __forceinline__ void convert_item4(const Params& p, int layer, int it0, float* sT) {
  unsigned char* wb = p.ws + (size_t)(layer & 1) * WBUF;
  const float* W; bf16_t* WT; int K, N, ntn, r = it0;
  if (r < CV_IN) { W = p.w_in + (size_t)layer * 1024 * INC; K = 1024; N = INC; WT = (bf16_t*)(wb + WS_WIN); ntn = 64; }
  else if ((r -= CV_IN) < CV_OUT) { W = p.w_out + (size_t)layer * 1024 * 1024; K = 1024; N = 1024; WT = (bf16_t*)(wb + WS_WOUT); ntn = 16; }
  else if ((r -= CV_OUT) < CV_1) { W = p.mlp_w1 + (size_t)layer * 1024 * 4096; K = 1024; N = 4096; WT = (bf16_t*)(wb + WS_W1); ntn = 64; }
  else { r -= CV_1; W = p.mlp_w2 + (size_t)layer * 4096 * 1024; K = 4096; N = 1024; WT = (bf16_t*)(wb + WS_W2); ntn = 16; }
  int tid_l = threadIdx.x; asm volatile("" : "+v"(tid_l));
  const int tid = tid_l;
  __syncthreads();
#pragma unroll
  for (int q = 0; q < 4; ++q) {
    const int tile = r + q, k0 = (tile / ntn) * 64, n0 = (tile % ntn) * 64;
#pragma unroll
    for (int i = 0; i < 8; ++i) {
      const int e = tid + i * 512, kk = e >> 6, nn = e & 63;
      sT[q * 4160 + kk * 65 + nn] = (n0 + nn < N) ? W[(size_t)(k0 + kk) * N + n0 + nn] : 0.f;
    }
  }
  __syncthreads();
  const int n = tid >> 3, kc = (tid & 7) * 8;
#pragma unroll
  for (int q = 0; q < 4; ++q) {
    const int tile = r + q, k0 = (tile / ntn) * 64, n0 = (tile % ntn) * 64;
    float v[8];
#pragma unroll
    for (int e = 0; e < 8; ++e) v[e] = sT[q * 4160 + (kc + e) * 65 + n];
    st8bf(WT + (size_t)(n0 + n) * K + k0 + kc, v);
  }
}
__device__ __forceinline__ void convert_weights(const Params& p, int layer, unsigned char* lds) {
  float* sT = (float*)lds;
  for (int it = blockIdx.x * 4; it < CV_ALL; it += gridDim.x * 4) convert_item4(p, layer, it, sT);
  __syncthreads();
}

__device__ __forceinline__ void norm_phase(const Params& p, int layer, int which  ) {
  int tid_l = threadIdx.x; asm volatile("" : "+v"(tid_l));
  const int lane = tid_l & 63, wv = tid_l >> 6;
  const float* nw = (which ? p.norm2_w : p.norm1_w) + layer * D;
  const float* mod = (const float*)(p.ws + WS_MOD) + (size_t)layer * 5 * 6144 + which * 3072;
  bf16_t* H = (bf16_t*)(p.ws + WS_H);
  for (int base = (blockIdx.x * 8 + wv) * 8; base < T; base += gridDim.x * 64) {
    const float* mr = mod + (size_t)cond_row(base) * 6144;
    f32x4 ws[4], sh[4];
#pragma unroll
    for (int j = 0; j < 4; ++j) { const int col = j * 256 + lane * 4; ws[j] = *(const f32x4*)(nw + col) * (*(const f32x4*)(mr + 1024 + col) + 1.f); sh[j] = *(const f32x4*)(mr + col); }
#pragma unroll
    for (int hf = 0; hf < 2; ++hf) {
      f32x4 v[4][4]; float ss[4];
#pragma unroll
      for (int i = 0; i < 4; ++i) { const int row = base + hf * 4 + i;
        const float* xr = which ? (const float*)(p.ws + WS_X) + (size_t)row * D : xrow_ptr(p, layer, row);
#pragma unroll
        for (int j = 0; j < 4; ++j) v[i][j] = *(const f32x4*)(xr + j * 256 + lane * 4); }
#pragma unroll
      for (int i = 0; i < 4; ++i) { float a = 0.f;
#pragma unroll
        for (int j = 0; j < 4; ++j) a += v[i][j].x * v[i][j].x + v[i][j].y * v[i][j].y + v[i][j].z * v[i][j].z + v[i][j].w * v[i][j].w;
        ss[i] = a; }
#pragma unroll
      for (int o = 32; o >= 1; o >>= 1) {
#pragma unroll
        for (int i = 0; i < 4; ++i) ss[i] += __shfl_xor(ss[i], o); }
#pragma unroll
      for (int i = 0; i < 4; ++i) { const int row = base + hf * 4 + i; const float rstd = rsqrtf(ss[i] * (1.f / D) + EPS);
#pragma unroll
        for (int j = 0; j < 4; ++j) { const f32x4 o = v[i][j] * rstd * ws[j] + sh[j];
          u32x2 pk; pk.x = pk2(o.x, o.y); pk.y = pk2(o.z, o.w);
          *(u32x2*)(H + (size_t)row * D + j * 256 + lane * 4) = pk; } }
    }
  }
}
__device__ __forceinline__ void final_norm(const Params& p) {
  int tid_l = threadIdx.x; asm volatile("" : "+v"(tid_l));
  const int lane = tid_l & 63, wv = tid_l >> 6;
  f32x4 w4[4];
#pragma unroll
  for (int j = 0; j < 4; ++j) w4[j] = *(const f32x4*)(p.final_norm_w + j * 256 + lane * 4);
  for (int base = (blockIdx.x * 8 + wv) * 8; base < T; base += gridDim.x * 64) {
#pragma unroll
    for (int hf = 0; hf < 2; ++hf) {
      f32x4 v[4][4]; float ss[4];
#pragma unroll
      for (int i = 0; i < 4; ++i) { const float* xr = (const float*)(p.ws + WS_X) + (size_t)(base + hf * 4 + i) * D;
#pragma unroll
        for (int j = 0; j < 4; ++j) v[i][j] = *(const f32x4*)(xr + j * 256 + lane * 4); }
#pragma unroll
      for (int i = 0; i < 4; ++i) { float a = 0.f;
#pragma unroll
        for (int j = 0; j < 4; ++j) a += v[i][j].x * v[i][j].x + v[i][j].y * v[i][j].y + v[i][j].z * v[i][j].z + v[i][j].w * v[i][j].w;
        ss[i] = a; }
#pragma unroll
      for (int o = 32; o >= 1; o >>= 1) {
#pragma unroll
        for (int i = 0; i < 4; ++i) ss[i] += __shfl_xor(ss[i], o); }
#pragma unroll
      for (int i = 0; i < 4; ++i) { const float rstd = rsqrtf(ss[i] * (1.f / D) + EPS);
#pragma unroll
        for (int j = 0; j < 4; ++j) *(f32x4*)(p.out + (size_t)(base + hf * 4 + i) * D + j * 256 + lane * 4) = v[i][j] * rstd * w4[j]; }
    }
  }
}

template <bool SSD>
__device__ __forceinline__ void decay_task(const Params& p, int layer, int seq, int head, int dir, unsigned char* lds) {
  constexpr int KD = SSD ? 128 : 64, LQ = KD + 8, NST = KD / 32;
  bf16_t* sQ = (bf16_t*)(lds + 64); bf16_t* sQs = sQ + 64 * LQ; bf16_t* sK = sQs + 64 * LQ; bf16_t* sSt = sK + 64 * LQ;
  bf16_t* sKdt = sSt + 64 * LQ; bf16_t* sVt = sKdt + KD * 72; bf16_t* sAtt = sVt + 64 * 72; bf16_t* sXs = sAtt + 64 * 72;
  float* sCum = (float*)(sXs + 64 * 72); float* sDt = sCum + 64; float* sCW = sDt + 64;
  const bf16_t* P = (const bf16_t*)(p.ws + WS_P);
  const float* gates = (const float*)(p.ws + WS_GATE);
  bf16_t* Odst = (bf16_t*)(p.ws + (dir ? WS_OB : WS_MIX));
  int tid_l = threadIdx.x; asm volatile("" : "+v"(tid_l));
  const int tid = tid_l, lane = tid & 63, w = tid >> 6, r = tid >> 3, sub = tid & 7;
  const bool sample = seq >= 32; const int L = sample ? 2048 : 256, seqbase = sample ? TP + (seq - 32) * 2048 : seq * 256, nch = L / 64;
  const int tr = w >> 1, tcs = (w & 1) * NST, tca = (w & 1) * 2;
  const int gidx = (layer * 2 + dir) * 4 + head;
  const int colbase = SSD ? 768 : 0;
  f32x4 accS[NST];
  if (sample) {
    const float* src = (SSD ? p.state_ssd : p.state_ret) + ((((size_t)(seq - 32) * 4 + layer) * 2 + dir) * 4 + head) * (KD * 64);
#pragma unroll
    for (int q = 0; q < NST; ++q) accS[q] = *(const f32x4*)(src + (16 * (tcs + q) + (lane & 15)) * 64 + 16 * tr + (lane >> 4) * 4);
  } else {
#pragma unroll
    for (int q = 0; q < NST; ++q) accS[q] = (f32x4){0.f, 0.f, 0.f, 0.f};
  }
  const float la_ret = SSD ? 0.f : p.ret_log_decay[gidx];
  const float Aneg = SSD ? -expf(p.ssd_A_log[gidx]) : 0.f, dtb = SSD ? p.ssd_dt_bias[gidx] : 0.f, Dh = SSD ? p.ssd_D[layer * 4 + head] : 0.f;
  const int grp = head >> 1;

  u32x4 xr[5][3]; float graw = 0.f;
  if constexpr (SSD) {
    const float* cw = p.ssd_conv_w + (size_t)layer * 3 * 768; const float* cb = p.ssd_conv_b + layer * 768;
    for (int i = tid; i < 1280; i += 512) { const int g5 = i >> 8, tap = (i >> 6) & 3, c = i & 63;
      const int chb = g5 == 0 ? head * 64 : (g5 <= 2 ? 256 + grp * 128 + (g5 - 1) * 64 : 512 + grp * 128 + (g5 - 3) * 64);
      sCW[i] = tap < 3 ? cw[tap * 768 + chb + c] : cb[chb + c]; }
    const int t0 = dir ? L - 1 - r : r, dm = t0 > 0 ? -NP : 0, dp = t0 < L - 1 ? NP : 0;
    const bf16_t* pr0 = P + (size_t)(seqbase + t0) * NP + C_SX + sub * 8;
    int gc[5]; gc[0] = head * 64; gc[1] = 256 + grp * 128; gc[2] = gc[1] + 64; gc[3] = 512 + grp * 128; gc[4] = gc[3] + 64;
#pragma unroll
    for (int g5 = 0; g5 < 5; ++g5) { const bf16_t* pc = pr0 + gc[g5]; xr[g5][0] = *(const u32x4*)(pc + dm); xr[g5][1] = *(const u32x4*)pc; xr[g5][2] = *(const u32x4*)(pc + dp); }
    if (tid < 64) { const int t2 = dir ? L - 1 - tid : tid; graw = gates[(size_t)(seqbase + t2) * 32 + 16 + dir * 4 + head]; }
    __syncthreads();
  }
  for (int n = 0; n < nch; ++n) {
    int tid_c = tid; asm volatile("" : "+v"(tid_c));
    const int tid = tid_c, lane = tid & 63, w = tid >> 6, r = tid >> 3, sub = tid & 7;
    const int tr = w >> 1, tcs = (w & 1) * NST, tca = (w & 1) * 2;
    const int pos = n * 64 + r, t = dir ? L - 1 - pos : pos;
    const bf16_t* prow = P + (size_t)(seqbase + t) * NP;
    float qv[KD / 64][8], kv[KD / 64][8], vv[8], xs[8];
    if constexpr (!SSD) {
      ld8(prow + C_RQ + head * 64 + sub * 8, qv[0]); ld8(prow + C_RK + head * 64 + sub * 8, kv[0]); ld8(prow + C_RV + head * 64 + sub * 8, vv);
#pragma unroll
      for (int e = 0; e < 8; ++e) kv[0][e] *= 0.125f;
      if (sample) {
        const float rowpos = (float)(t >> 6), colpos = (float)(t & 63);
#pragma unroll
        for (int e = 0; e < 8; ++e) {
          const int i = (sub & 3) * 8 + e;
          const float inv = exp2f(-(float)(i & 15) * (13.287712379549449f / 16.0f));
          const float ang = (i < 16 ? rowpos : colpos) * inv;
          float sn, cs; __sincosf(ang, &sn, &cs);
          const float oq = __shfl_xor(qv[0][e], 4), ok = __shfl_xor(kv[0][e], 4);
          if (sub < 4) { qv[0][e] = qv[0][e] * cs - oq * sn; kv[0][e] = kv[0][e] * cs - ok * sn; }
          else { qv[0][e] = oq * sn + qv[0][e] * cs; kv[0][e] = ok * sn + kv[0][e] * cs; }
        }
      }
    } else {
      const float m0 = t > 0 ? 1.f : 0.f, m2 = t < L - 1 ? 1.f : 0.f;
#pragma unroll
      for (int g5 = 0; g5 < 5; ++g5) {
        float x0[8], x1[8], x2[8], w0[8], w1[8], w2[8], bb[8];
        asm volatile("" : "+v"(xr[g5][0]), "+v"(xr[g5][1]), "+v"(xr[g5][2]));
        ldf8(sCW + (g5 * 4 + 0) * 64 + sub * 8, w0); ldf8(sCW + (g5 * 4 + 1) * 64 + sub * 8, w1); ldf8(sCW + (g5 * 4 + 2) * 64 + sub * 8, w2); ldf8(sCW + (g5 * 4 + 3) * 64 + sub * 8, bb);
        ld8v(xr[g5][0], x0); ld8v(xr[g5][1], x1); ld8v(xr[g5][2], x2);
#pragma unroll
        for (int e2 = 0; e2 < 8; ++e2) { float o = silu_f(bb[e2] + x1[e2] * w1[e2] + m0 * (x0[e2] * w0[e2]) + m2 * (x2[e2] * w2[e2]));
          asm volatile("" : "+v"(o));
          if (g5 == 0) xs[e2] = o; else if (g5 == 1) kv[0][e2] = o; else if (g5 == 2) kv[1][e2] = o; else if (g5 == 3) qv[0][e2] = o; else qv[1][e2] = o; }
        asm volatile("" ::: "memory");
      }
    }
    const float graw_c = graw;
    if constexpr (SSD) {
      if (n + 1 < nch) {
        const int pos1 = (n + 1) * 64 + r, t1 = dir ? L - 1 - pos1 : pos1, dm = t1 > 0 ? -NP : 0, dp = t1 < L - 1 ? NP : 0;
        const bf16_t* pr1 = P + (size_t)(seqbase + t1) * NP + C_SX + sub * 8;
        int gc[5]; gc[0] = head * 64; gc[1] = 256 + grp * 128; gc[2] = gc[1] + 64; gc[3] = 512 + grp * 128; gc[4] = gc[3] + 64;
#pragma unroll
        for (int g5 = 0; g5 < 5; ++g5) { const bf16_t* pc = pr1 + gc[g5]; xr[g5][0] = *(const u32x4*)(pc + dm); xr[g5][1] = *(const u32x4*)pc; xr[g5][2] = *(const u32x4*)(pc + dp); }
        if (tid < 64) { const int pos2 = (n + 1) * 64 + tid, t2 = dir ? L - 1 - pos2 : pos2; graw = gates[(size_t)(seqbase + t2) * 32 + 16 + dir * 4 + head]; }
      }
    }
    if (tid < 64) {
      float la, dtv = 0.f;
      if constexpr (SSD) {
        dtv = softplus_f(graw_c + dtb); la = Aneg * dtv;
      } else la = la_ret;
      float c = la;
#pragma unroll
      for (int o = 1; o < 64; o <<= 1) { const float y = __shfl_up(c, o); if (lane >= o) c += y; }
      sCum[tid] = c; sDt[tid] = dtv;
    }
    __syncthreads();
    const float cum_r = sCum[r], last = sCum[63];
    const float eq = __expf(cum_r), ek = __expf(last - cum_r);
    if constexpr (SSD) { const float dt_r = sDt[r];
#pragma unroll
      for (int e = 0; e < 8; ++e) vv[e] = xs[e] * dt_r;
      st8bf(sXs + r * 72 + sub * 8, xs); }
#pragma unroll
    for (int g = 0; g < KD / 64; ++g) {
      st8bf(sQ + r * LQ + g * 64 + sub * 8, qv[g]); st8bf(sK + r * LQ + g * 64 + sub * 8, kv[g]);
      float qs[8];
#pragma unroll
      for (int e = 0; e < 8; ++e) { qs[e] = qv[g][e] * eq; sKdt[(g * 64 + sub * 8 + e) * 72 + (r ^ ((sub >> 1) << 4))] = f2bf(kv[g][e] * ek); }
      st8bf(sQs + r * LQ + g * 64 + sub * 8, qs);
    }
#pragma unroll
    for (int e = 0; e < 8; ++e) sVt[(sub * 8 + e) * 72 + (r ^ ((sub >> 1) << 4))] = f2bf(vv[e]);
#pragma unroll
    for (int q = 0; q < NST; ++q)
#pragma unroll
      for (int j = 0; j < 4; ++j) sSt[(16 * tr + (lane >> 4) * 4 + j) * LQ + 16 * (tcs + q) + (lane & 15)] = f2bf(accS[q][j]);
    __syncthreads();
    f32x4 accO[2];
#pragma unroll
    for (int c2 = 0; c2 < 2; ++c2) {
      const int tc = tca + c2;
      f32x4 a = mma_tile(sQ + 16 * tr * LQ, LQ, sK + 16 * tc * LQ, LQ, KD, (f32x4){0.f, 0.f, 0.f, 0.f}, lane);
      accO[c2] = mma_tile(sQs + 16 * tr * LQ, LQ, sSt + 16 * tc * LQ, LQ, KD, (f32x4){0.f, 0.f, 0.f, 0.f}, lane);
      const int jj = 16 * tc + (lane & 15); const float cj = sCum[jj];
#pragma unroll
      for (int j = 0; j < 4; ++j) { const int i = 16 * tr + (lane >> 4) * 4 + j;
        const float val = (jj <= i) ? a[j] * __expf(sCum[i] - cj) : 0.f; sAtt[i * 72 + jj] = f2bf(val); }
    }
    __syncthreads();
#pragma unroll
    for (int c2 = 0; c2 < 2; ++c2) {
      const int tc = tca + c2;
      accO[c2] = mma_tile(sAtt + 16 * tr * 72, 72, sVt + 16 * tc * 72, 72, 64, accO[c2], lane, 0, (tc & 3) << 4);
      const int v = 16 * tc + (lane & 15);
#pragma unroll
      for (int j = 0; j < 4; ++j) { const int i = 16 * tr + (lane >> 4) * 4 + j;
        float o = accO[c2][j];
        if constexpr (SSD) { if (dir == 0) o += bf2f(sXs[i * 72 + v]) * Dh; }
        sQ[i * LQ + v] = f2bf(o); }
    }
    const float el = __expf(last);
#pragma unroll
    for (int q = 0; q < NST; ++q) { accS[q] = accS[q] * el; accS[q] = mma_tile(sVt + 16 * tr * 72, 72, sKdt + 16 * (tcs + q) * 72, 72, 64, accS[q], lane, (tr & 3) << 4, ((tcs + q) & 3) << 4); }
    __syncthreads();
    *(u32x4*)(Odst + (size_t)(seqbase + t) * D + colbase + head * 64 + sub * 8) = *(const u32x4*)(sQ + r * LQ + sub * 8);
  }
  if (!sample) {
    float* dst = p.out + (SSD ? OUT_SSD : OUT_RET) + ((((size_t)seq * 4 + layer) * 2 + dir) * 4 + head) * (KD * 64);
#pragma unroll
    for (int q = 0; q < NST; ++q) *(f32x4*)(dst + (16 * (tcs + q) + (lane & 15)) * 64 + 16 * tr + (lane >> 4) * 4) = accS[q];
  }
}

__device__ __forceinline__ void unpk8(u32x4 v, float (&o)[8]) {
  o[0] = __uint_as_float(v.x << 16); o[1] = __uint_as_float(v.x & 0xffff0000u); o[2] = __uint_as_float(v.y << 16); o[3] = __uint_as_float(v.y & 0xffff0000u);
  o[4] = __uint_as_float(v.z << 16); o[5] = __uint_as_float(v.z & 0xffff0000u); o[6] = __uint_as_float(v.w << 16); o[7] = __uint_as_float(v.w & 0xffff0000u); }
template <int OFF> __device__ __forceinline__ f32x4 lds_rd128(unsigned addr) { f32x4 v; asm volatile("ds_read_b128 %0, %1 offset:%2" : "=v"(v) : "v"(addr), "n"(OFF)); return v; }
template <int J> struct SolveStep {
  static __device__ __forceinline__ void run(f32x2v (&rr2)[8], f32x4 (&Ac)[4], unsigned apaddr, int part) {
    constexpr int mj = J >> 2, pj = J & 3, ip = mj >> 1, ie = mj & 1;
    f32x4 An[4];
    if constexpr (J < 62) {
      An[0] = lds_rd128<(J + 1) * 272 + 0>(apaddr); An[1] = lds_rd128<(J + 1) * 272 + 16>(apaddr); An[2] = lds_rd128<(J + 1) * 272 + 32>(apaddr); An[3] = lds_rd128<(J + 1) * 272 + 48>(apaddr);
      asm volatile("s_waitcnt lgkmcnt(4)" : "+v"(Ac[0]), "+v"(Ac[1]), "+v"(Ac[2]), "+v"(Ac[3]));
    } else {
      asm volatile("s_waitcnt lgkmcnt(0)" : "+v"(Ac[0]), "+v"(Ac[1]), "+v"(Ac[2]), "+v"(Ac[3]));
    }
    const float xj = __int_as_float(__builtin_amdgcn_mov_dpp(__float_as_int(rr2[ip][ie]), pj * 0x55, 0xf, 0xf, false));
    rr2[ip][ie] -= (part > pj ? Ac[mj >> 2][mj & 3] : 0.f) * xj;
    if constexpr (ie == 0) rr2[ip][1] -= Ac[(mj + 1) >> 2][(mj + 1) & 3] * xj;
    const f32x2v x2 = (f32x2v){xj, xj};
#pragma unroll
    for (int i = ip + 1; i < 8; ++i) {
      const f32x2v a2 = (i & 1) ? __builtin_shufflevector(Ac[i >> 1], Ac[i >> 1], 2, 3) : __builtin_shufflevector(Ac[i >> 1], Ac[i >> 1], 0, 1);
      rr2[i] = rr2[i] - a2 * x2;
    }
    if constexpr (J < 62) SolveStep<J + 1>::run(rr2, An, apaddr, part);
  }
};
template <int K> __device__ __forceinline__ float quad_bcast(float v) { return __int_as_float(__builtin_amdgcn_mov_dpp(__float_as_int(v), K * 0x55, 0xf, 0xf, false)); }
__device__ __forceinline__ void gdn_task(const Params& p, int layer, int seq, int head, int dir, unsigned char* lds) {
  constexpr int LQ = 72;
  bf16_t* sQ = (bf16_t*)(lds + 64); bf16_t* sQs = sQ + 64 * LQ; bf16_t* sK = sQs + 64 * LQ; bf16_t* sSt = sK + 64 * LQ;
  bf16_t* sKdt = sSt + 64 * LQ; bf16_t* sAtt = sKdt + 64 * LQ; bf16_t* sVNt = sAtt + 64 * LQ; bf16_t* sW = sVNt + 64 * LQ;
  float* sA = (float*)(sW + 64 * LQ);
  float* sR = sA + 64 * 68;
  float* sCum = sR + 64 * 132; float* sBeta = sCum + 64; float* sCW = sBeta + 64;
  const bf16_t* P = (const bf16_t*)(p.ws + WS_P);
  const float* gates = (const float*)(p.ws + WS_GATE);
  bf16_t* Odst = (bf16_t*)(p.ws + (dir ? WS_OB : WS_MIX));
  int tid_l = threadIdx.x; asm volatile("" : "+v"(tid_l));
  const int tid0 = tid_l;
  const bool sample = seq >= 32; const int L = sample ? 2048 : 256, seqbase = sample ? TP + (seq - 32) * 2048 : seq * 256, nch = L / 64;
  int tr, tca, lane;
  { const int w0 = tid0 >> 6; tr = w0 >> 1; tca = (w0 & 1) * 2; lane = tid0 & 63; }
  const int gidx = (layer * 2 + dir) * 4 + head;
  f32x4 accS[2];
  if (sample) {
    const float* src = p.state_gdn + ((((size_t)(seq - 32) * 4 + layer) * 2 + dir) * 4 + head) * 4096;
#pragma unroll
    for (int q = 0; q < 2; ++q) accS[q] = *(const f32x4*)(src + (16 * (tca + q) + (lane & 15)) * 64 + 16 * tr + (lane >> 4) * 4);
  } else {
#pragma unroll
    for (int q = 0; q < 2; ++q) accS[q] = (f32x4){0.f, 0.f, 0.f, 0.f};
  }
  const float Aneg = -expf(p.gdn_A_log[gidx]), dtb = p.gdn_dt_bias[gidx];
  const float* cw = p.gdn_conv_w + (size_t)layer * 3 * 768;

  const bf16_t* Pseq = P + (size_t)seqbase * NP + C_GQ + head * 64;
  for (int i = tid0; i < 576; i += 512) { const int a3 = i / 192, tap = (i % 192) >> 6, c = i & 63; sCW[i] = cw[tap * 768 + a3 * 256 + head * 64 + c]; }
  u32x4 xr[3][3]; float ga = 0.f, gb = 0.f;
  { const int r0 = tid0 >> 3, pos0 = r0, t0 = dir ? L - 1 - pos0 : pos0, tm = t0 > 0 ? t0 - 1 : 0, tp = t0 < L - 1 ? t0 + 1 : L - 1;
    const bf16_t* pb = Pseq + (tid0 & 7) * 8;
#pragma unroll
    for (int a3 = 0; a3 < 3; ++a3) { xr[a3][0] = *(const u32x4*)(pb + (size_t)tm * NP + a3 * 256); xr[a3][1] = *(const u32x4*)(pb + (size_t)t0 * NP + a3 * 256); xr[a3][2] = *(const u32x4*)(pb + (size_t)tp * NP + a3 * 256); }
    if (tid0 < 64) { const int t2 = dir ? L - 1 - tid0 : tid0; const float* gr = gates + (size_t)(seqbase + t2) * 32; ga = gr[dir * 4 + head]; gb = gr[8 + dir * 4 + head]; } }
  __syncthreads();
  for (int n = 0; n < nch; ++n) {
    int tid_c = tid0; asm volatile("" : "+v"(tid_c));
    const int tid = tid_c, r = tid >> 3, sub = tid & 7;
    lane = tid & 63; { const int w1 = tid >> 6; tr = w1 >> 1; tca = (w1 & 1) * 2; }
    const int pos = n * 64 + r, t = dir ? L - 1 - pos : pos;
    float qv[8], kv[8], vv[8];
    { const float m0 = t > 0 ? 1.f : 0.f, m2 = t < L - 1 ? 1.f : 0.f;
#pragma unroll
      for (int a3 = 0; a3 < 3; ++a3) {
        float x0[8], x1[8], x2[8], w0[8], w1[8], w2[8];
        unpk8(xr[a3][0], x0); unpk8(xr[a3][1], x1); unpk8(xr[a3][2], x2);
        ldf8(sCW + (a3 * 3 + 0) * 64 + sub * 8, w0); ldf8(sCW + (a3 * 3 + 1) * 64 + sub * 8, w1); ldf8(sCW + (a3 * 3 + 2) * 64 + sub * 8, w2);
#pragma unroll
        for (int e2 = 0; e2 < 8; ++e2) { const float o = x1[e2] * w1[e2] + m0 * (x0[e2] * w0[e2]) + m2 * (x2[e2] * w2[e2]); if (a3 == 0) qv[e2] = o; else if (a3 == 1) kv[e2] = o; else vv[e2] = o; }
      } }
    const float ga_c = ga, gb_c = gb;
    if (n + 1 < nch) {
      const int pos1 = (n + 1) * 64 + r, t1 = dir ? L - 1 - pos1 : pos1, tm = t1 > 0 ? t1 - 1 : 0, tp = t1 < L - 1 ? t1 + 1 : L - 1;
      const bf16_t* pb = Pseq + sub * 8;
#pragma unroll
      for (int a3 = 0; a3 < 3; ++a3) { xr[a3][0] = *(const u32x4*)(pb + (size_t)tm * NP + a3 * 256); xr[a3][1] = *(const u32x4*)(pb + (size_t)t1 * NP + a3 * 256); xr[a3][2] = *(const u32x4*)(pb + (size_t)tp * NP + a3 * 256); }
      if (tid < 64) { const int pos2 = (n + 1) * 64 + tid, t2 = dir ? L - 1 - pos2 : pos2; const float* gr = gates + (size_t)(seqbase + t2) * 32; ga = gr[dir * 4 + head]; gb = gr[8 + dir * 4 + head]; }
    }
    float sq = 0.f, sk = 0.f;
#pragma unroll
    for (int e = 0; e < 8; ++e) { qv[e] = silu_f(qv[e]); kv[e] = silu_f(kv[e]); vv[e] = silu_f(vv[e]); sq += qv[e] * qv[e]; sk += kv[e] * kv[e]; }
    sq += __shfl_xor(sq, 1); sq += __shfl_xor(sq, 2); sq += __shfl_xor(sq, 4);
    sk += __shfl_xor(sk, 1); sk += __shfl_xor(sk, 2); sk += __shfl_xor(sk, 4);
    const float rq = rsqrtf(sq + EPS) * 0.125f, rk = rsqrtf(sk + EPS);
#pragma unroll
    for (int e = 0; e < 8; ++e) { qv[e] *= rq; kv[e] *= rk; }
    if (tid < 64) {
      const float la = Aneg * softplus_f(ga_c + dtb);
      float c = la;
#pragma unroll
      for (int o = 1; o < 64; o <<= 1) { const float y = __shfl_up(c, o); if (lane >= o) c += y; }
      sCum[tid] = c; sBeta[tid] = sigmoid_f(gb_c);
    }
    __syncthreads();
    const float cum_r = sCum[r], last = sCum[63], beta_r = sBeta[r];
    const float eq = __expf(cum_r), ek = __expf(last - cum_r);
    st8bf(sQ + r * LQ + sub * 8, qv); st8bf(sK + r * LQ + sub * 8, kv);
    { float qs[8];
#pragma unroll
      for (int e = 0; e < 8; ++e) { qs[e] = qv[e] * eq; sKdt[(sub * 8 + e) * LQ + (r ^ ((sub >> 1) << 4))] = f2bf(kv[e] * ek);
        sR[r * 132 + sub * 8 + e] = kv[e] * (beta_r * eq); sR[r * 132 + 64 + sub * 8 + e] = vv[e] * beta_r; }
      st8bf(sQs + r * LQ + sub * 8, qs); }
#pragma unroll
    for (int q = 0; q < 2; ++q)
#pragma unroll
      for (int j = 0; j < 4; ++j) sSt[(16 * tr + (lane >> 4) * 4 + j) * LQ + 16 * (tca + q) + (lane & 15)] = f2bf(accS[q][j]);
    __syncthreads();
    f32x4 accO[2];
#pragma unroll
    for (int c2 = 0; c2 < 2; ++c2) {
      const int tc = tca + c2;
      const f32x4 kk = mma_tile(sK + 16 * tr * LQ, LQ, sK + 16 * tc * LQ, LQ, 64, (f32x4){0.f, 0.f, 0.f, 0.f}, lane);
      const f32x4 qk = mma_tile(sQ + 16 * tr * LQ, LQ, sK + 16 * tc * LQ, LQ, 64, (f32x4){0.f, 0.f, 0.f, 0.f}, lane);
      accO[c2] = mma_tile(sQs + 16 * tr * LQ, LQ, sSt + 16 * tc * LQ, LQ, 64, (f32x4){0.f, 0.f, 0.f, 0.f}, lane);
      const int jj = 16 * tc + (lane & 15); const float cj = sCum[jj];
#pragma unroll
      for (int j = 0; j < 4; ++j) { const int i = 16 * tr + (lane >> 4) * 4 + j;
        const float dec = (jj <= i) ? __expf(sCum[i] - cj) : 0.f;
        sA[jj * 68 + (i & 3) * 16 + (i >> 2)] = (jj < i) ? kk[j] * dec * sBeta[i] : 0.f;
        sAtt[i * LQ + jj] = f2bf(qk[j] * dec); }
    }
    __syncthreads();
    {
      int tid_s = tid0; asm volatile("" : "+v"(tid_s));
      const int col = tid_s >> 2, part = tid_s & 3;
      float* rb = sR + part * 132 + col;
      const unsigned apaddr = (unsigned)(size_t)(XLAS float*)(sA + part * 16);
      f32x2v rr2[8];
#pragma unroll
      for (int m = 0; m < 16; ++m) rr2[m >> 1][m & 1] = rb[m * 528];
      asm volatile("s_waitcnt lgkmcnt(0)" ::: "memory");
      f32x4 A0[4];
      A0[0] = lds_rd128<0>(apaddr); A0[1] = lds_rd128<16>(apaddr); A0[2] = lds_rd128<32>(apaddr); A0[3] = lds_rd128<48>(apaddr);
      SolveStep<0>::run(rr2, A0, apaddr, part);
      float rr[16];
#pragma unroll
      for (int m = 0; m < 16; ++m) rr[m] = rr2[m >> 1][m & 1];
      if (col < 64) {
        bf16_t* wb = sW + part * LQ + col;
#pragma unroll
        for (int m = 0; m < 16; ++m) wb[m * 4 * LQ] = f2bf(rr[m]);
      } else {
#pragma unroll
        for (int m = 0; m < 16; ++m) rb[m * 528] = rr[m];
      }
    }
    __syncthreads();
    { int tid_p = tid0; asm volatile("" : "+v"(tid_p)); lane = tid_p & 63; const int w2 = tid_p >> 6; tr = w2 >> 1; tca = (w2 & 1) * 2; }
#pragma unroll
    for (int c2 = 0; c2 < 2; ++c2) {
      const int tc = tca + c2;
      const f32x4 ws = mma_tile(sW + 16 * tr * LQ, LQ, sSt + 16 * tc * LQ, LQ, 64, (f32x4){0.f, 0.f, 0.f, 0.f}, lane);
      const int v = 16 * tc + (lane & 15);
#pragma unroll
      for (int j = 0; j < 4; ++j) { const int cI = 16 * tr + (lane >> 4) * 4 + j; sVNt[v * LQ + cI] = f2bf(sR[cI * 132 + 64 + v] - ws[j]); }
    }
    __syncthreads();
#pragma unroll
    for (int c2 = 0; c2 < 2; ++c2) {
      const int tc = tca + c2;
      accO[c2] = mma_tile(sAtt + 16 * tr * LQ, LQ, sVNt + 16 * tc * LQ, LQ, 64, accO[c2], lane);
      const int v = 16 * tc + (lane & 15);
#pragma unroll
      for (int j = 0; j < 4; ++j) { const int i = 16 * tr + (lane >> 4) * 4 + j;
        sQ[i * LQ + v] = f2bf(accO[c2][j]); }
    }
    const float el = __expf(last);
#pragma unroll
    for (int q = 0; q < 2; ++q) { accS[q] = accS[q] * el; accS[q] = mma_tile(sVNt + 16 * tr * LQ, LQ, sKdt + 16 * (tca + q) * LQ, LQ, 64, accS[q], lane, 0, ((tca + q) & 3) << 4); }
    __syncthreads();
    { int tid_o = tid0; asm volatile("" : "+v"(tid_o)); const int ro = tid_o >> 3, so = tid_o & 7, po = n * 64 + ro, to = dir ? L - 1 - po : po;
      *(u32x4*)(Odst + (size_t)(seqbase + to) * D + 512 + head * 64 + so * 8) = *(const u32x4*)(sQ + ro * LQ + so * 8); }
  }
  if (!sample) {
    float* dst = p.out + OUT_GDN + ((((size_t)seq * 4 + layer) * 2 + dir) * 4 + head) * 4096;
#pragma unroll
    for (int q = 0; q < 2; ++q) *(f32x4*)(dst + (16 * (tca + q) + (lane & 15)) * 64 + 16 * tr + (lane >> 4) * 4) = accS[q];
  }
}

__device__ __forceinline__ void unpk4(u32x2 v, float (&o)[4]) { o[0] = __uint_as_float(v.x << 16); o[1] = __uint_as_float(v.x & 0xffff0000u); o[2] = __uint_as_float(v.y << 16); o[3] = __uint_as_float(v.y & 0xffff0000u); }
__device__ __forceinline__ void hy1_task(const Params& p, int layer, int g, unsigned char* lds) {
  const bf16_t* P = (const bf16_t*)(p.ws + WS_P);
  bf16_t* Ut = (bf16_t*)(p.ws + WS_U); bf16_t* X0t = (bf16_t*)(p.ws + WS_X0);
  bf16_t* sTu = (bf16_t*)(lds + 64); bf16_t* sTx = sTu + 256 * 72;
  int tid_l = threadIdx.x; asm volatile("" : "+v"(tid_l));
  const int tid = tid_l, r = tid >> 3, sub = tid & 7;
  const int row = g * 64 + r;
  const bool sample = row >= TP; const int L = sample ? 2048 : 256, t = sample ? (row - TP) & 2047 : row & 255;
  const bf16_t* prow = P + (size_t)row * NP + C_HY;
  const float* cw = p.hy_conv_w + (size_t)layer * 3 * 768; const float* cb = p.hy_conv_b + layer * 768;
#pragma unroll
  for (int q = 0; q < 4; ++q) {
    const int ch = q * 64 + sub * 8;
    float x0[8], x1[8], v[8];
    conv8(prow + ch, t, L, cw + ch, cb + ch, x0); conv8(prow + 256 + ch, t, L, cw + 256 + ch, cb + 256 + ch, x1); conv8(prow + 512 + ch, t, L, cw + 512 + ch, cb + 512 + ch, v);
#pragma unroll
    for (int e = 0; e < 8; ++e) { sTu[(ch + e) * 72 + (r ^ ((sub >> 1) << 4))] = f2bf(v[e] * x1[e]); sTx[(ch + e) * 72 + (r ^ ((sub >> 1) << 4))] = f2bf(x0[e]); }
  }
  __syncthreads();
  const int c = tid >> 1, h = tid & 1;
#pragma unroll
  for (int i = 0; i < 4; ++i) {
    *(u32x4*)(Ut + (size_t)c * TS + g * 64 + h * 32 + i * 8) = *(const u32x4*)(sTu + c * 72 + ((h * 32 + i * 8) ^ (((c >> 4) & 3) << 4)));
    *(u32x4*)(X0t + (size_t)c * TS + g * 64 + h * 32 + i * 8) = *(const u32x4*)(sTx + c * 72 + ((h * 32 + i * 8) ^ (((c >> 4) & 3) << 4)));
  }
}

template <bool SAMPLE>
__device__ __forceinline__ void hy2_task(const Params& p, int layer, int c, unsigned char* lds) {
  constexpr int L = SAMPLE ? 2048 : 256, GL = 2 * L + 8, CSE = SAMPLE ? 4112 : 528, NE = L / 32;
  const int rowbase = SAMPLE ? TP : 0;
  bf16_t* sU = (bf16_t*)(lds + 64);
  bf16_t* sG = sU + 8192;
  bf16_t* sRaw = sG + 8 * CSE;
  int tid_l = threadIdx.x; asm volatile("" : "+v"(tid_l));
  const int tid = tid_l, lane = tid & 63, w = tid >> 6, q = lane >> 4, n = lane & 15;
  const bf16_t* Uc = (const bf16_t*)(p.ws + WS_U) + (size_t)c * TS + rowbase;
  const bf16_t* Gc = (const bf16_t*)(p.ws + WS_TAPS) + ((size_t)layer * 256 + c) * GT_CH + (SAMPLE ? GT_SOFF : 0);
#pragma unroll
  for (int i = 0; i < 2; ++i) *(u32x4*)(sU + (tid + i * 512) * 8) = *(const u32x4*)(Uc + (tid + i * 512) * 8);
  for (int v8 = tid; v8 < (GL + 8) / 8; v8 += 512) {
    u32x4 gv = *(const u32x4*)(Gc + v8 * 8);
    if (v8 == 0) gv.x &= 0xffff0000u;
    if (v8 * 8 >= 2 * L) gv = (u32x4){0u, 0u, 0u, 0u};
    *(u32x4*)(sRaw + v8 * 8) = gv;
  }
  __syncthreads();
  for (int idx = tid; idx < CSE; idx += 512) {
#pragma unroll
    for (int a = 0; a < 8; ++a) sG[a * CSE + idx] = (idx + a < GL + 8) ? sRaw[idx + a] : (bf16_t)0;
  }
  __syncthreads();
  f32x4 acc[2][2];
#pragma unroll
  for (int g = 0; g < 2; ++g)
#pragma unroll
    for (int rh = 0; rh < 2; ++rh) acc[g][rh] = (f32x4){0.f, 0.f, 0.f, 0.f};
  const int dlo = SAMPLE ? 8 * w - 63 : w - 7, dhi = SAMPLE ? 8 * w + 7 : w;
#pragma unroll 2
  for (int dp = dlo; dp <= dhi; ++dp) {
    bf16x8 fa[2];
#pragma unroll
    for (int rh = 0; rh < 2; ++rh) { const int m0 = L - 32 * dp - (16 * rh + n) + 8 * q; fa[rh] = *(const bf16x8*)(sG + (m0 & 7) * CSE + (m0 & ~7)); }
#pragma unroll
    for (int g = 0; g < 2; ++g) {
      const int a = SAMPLE ? 8 * w + 4 * g + (n >> 2) : w, b = SAMPLE ? (n & 3) : 16 * g + n;
      const int e = a - dp;
      bf16x8 fb = (bf16x8){0, 0, 0, 0, 0, 0, 0, 0};
      if ((unsigned)e < (unsigned)NE) fb = *(const bf16x8*)(sU + b * L + 32 * e + 8 * q);
      acc[g][0] = __builtin_amdgcn_mfma_f32_16x16x32_bf16(fa[0], fb, acc[g][0], 0, 0, 0);
      acc[g][1] = __builtin_amdgcn_mfma_f32_16x16x32_bf16(fa[1], fb, acc[g][1], 0, 0, 0);
    }
  }
  const float hb = p.hy_bias[layer * 256 + c];
  bf16_t* Yc = (bf16_t*)(p.ws + WS_Y) + (size_t)c * TS + rowbase;
  const bf16_t* Xc = (const bf16_t*)(p.ws + WS_X0) + (size_t)c * TS + rowbase;
#pragma unroll
  for (int g = 0; g < 2; ++g) {
    const int a = SAMPLE ? 8 * w + 4 * g + (n >> 2) : w, b = SAMPLE ? (n & 3) : 16 * g + n;
#pragma unroll
    for (int rh = 0; rh < 2; ++rh) {
      const int lrow = b * L + 32 * a + 16 * rh + q * 4;
      float u[4], x0[4];
      unpk4(*(const u32x2*)(sU + lrow), u); unpk4(*(const u32x2*)(Xc + lrow), x0);
      u32x2 o; o.x = pk2(x0[0] * (acc[g][rh][0] + u[0] * hb), x0[1] * (acc[g][rh][1] + u[1] * hb)); o.y = pk2(x0[2] * (acc[g][rh][2] + u[2] * hb), x0[3] * (acc[g][rh][3] + u[3] * hb));
      *(u32x2*)(Yc + lrow) = o;
    }
  }
}

__device__ __forceinline__ void finalize_rows(const Params& p, int layer, unsigned char* lds) {
  const bf16_t* P = (const bf16_t*)(p.ws + WS_P);
  bf16_t* MIX = (bf16_t*)(p.ws + WS_MIX); const bf16_t* OB = (const bf16_t*)(p.ws + WS_OB);
  const bf16_t* Yt = (const bf16_t*)(p.ws + WS_Y);
  bf16_t* sY = (bf16_t*)(lds + 64);
  int tid_l = threadIdx.x; asm volatile("" : "+v"(tid_l));
  const int tid = tid_l, lane = tid & 63, wv = tid >> 6, c4 = lane * 4;
  const f32x4 w_ret = *(const f32x4*)(p.ret_norm_w + layer * 256 + c4), w_hy = *(const f32x4*)(p.hy_norm_w + layer * 256 + c4);
  const f32x4 w_gdn = *(const f32x4*)(p.gdn_norm_w + layer * 256 + c4), w_ssd = *(const f32x4*)(p.ssd_norm_w + layer * 256 + c4);
  for (int tile = blockIdx.x; tile < T / 64; tile += gridDim.x) {
    __syncthreads();
    { const int c = tid >> 1, h = tid & 1;
#pragma unroll
      for (int i = 0; i < 4; ++i) *(u32x4*)(sY + c * 72 + h * 32 + i * 8) = *(const u32x4*)(Yt + (size_t)c * TS + tile * 64 + h * 32 + i * 8); }
    __syncthreads();
#pragma unroll 2
    for (int rr = 0; rr < 8; ++rr) {
      const int rl = wv * 8 + rr, row = tile * 64 + rl;
      bf16_t* mr = MIX + (size_t)row * D + c4; const bf16_t* br = OB + (size_t)row * D + c4; const bf16_t* pr = P + (size_t)row * NP + c4;
      const u32x2 m0 = *(const u32x2*)mr, m2 = *(const u32x2*)(mr + 512), m3 = *(const u32x2*)(mr + 768);
      const u32x2 b0 = *(const u32x2*)br, b2 = *(const u32x2*)(br + 512), b3 = *(const u32x2*)(br + 768);
      const u32x2 g0 = *(const u32x2*)(pr + C_RG), g2 = *(const u32x2*)(pr + C_GZ), g3 = *(const u32x2*)(pr + C_SZ);
      float a[4], b[4], g[4], o[4];
      u32x2 r0, r1, r2, r3;
      { unpk4(m0, a); unpk4(b0, b); unpk4(g0, g); float ss = 0.f;
#pragma unroll
        for (int e = 0; e < 4; ++e) { o[e] = a[e] + b[e]; ss += o[e] * o[e]; }
        ss += __shfl_xor(ss, 1); ss += __shfl_xor(ss, 2); ss += __shfl_xor(ss, 4); ss += __shfl_xor(ss, 8);
        const float rstd = rsqrtf(ss * (1.f / 64.f) + EPS);
        r0.x = pk2(o[0] * rstd * w_ret.x * silu_f(g[0]), o[1] * rstd * w_ret.y * silu_f(g[1])); r0.y = pk2(o[2] * rstd * w_ret.z * silu_f(g[2]), o[3] * rstd * w_ret.w * silu_f(g[3])); }
      {
#pragma unroll
        for (int e = 0; e < 4; ++e) o[e] = bf2f(sY[(c4 + e) * 72 + rl]);
        const float ss = o[0] * o[0] + o[1] * o[1] + o[2] * o[2] + o[3] * o[3];
        const float rstd = rsqrtf(wave_sum(ss) * (1.f / 256.f) + EPS);
        r1.x = pk2(o[0] * rstd * w_hy.x, o[1] * rstd * w_hy.y); r1.y = pk2(o[2] * rstd * w_hy.z, o[3] * rstd * w_hy.w); }
      { unpk4(m2, a); unpk4(b2, b); unpk4(g2, g); float ss = 0.f;
#pragma unroll
        for (int e = 0; e < 4; ++e) { o[e] = a[e] + b[e]; ss += o[e] * o[e]; }
        ss += __shfl_xor(ss, 1); ss += __shfl_xor(ss, 2); ss += __shfl_xor(ss, 4); ss += __shfl_xor(ss, 8);
        const float rstd = rsqrtf(ss * (1.f / 64.f) + EPS);
        r2.x = pk2(o[0] * rstd * w_gdn.x * silu_f(g[0]), o[1] * rstd * w_gdn.y * silu_f(g[1])); r2.y = pk2(o[2] * rstd * w_gdn.z * silu_f(g[2]), o[3] * rstd * w_gdn.w * silu_f(g[3])); }
      { unpk4(m3, a); unpk4(b3, b); unpk4(g3, g); float ss = 0.f;
#pragma unroll
        for (int e = 0; e < 4; ++e) { o[e] = (a[e] + b[e]) * silu_f(g[e]); ss += o[e] * o[e]; }
        ss += __shfl_xor(ss, 1); ss += __shfl_xor(ss, 2); ss += __shfl_xor(ss, 4); ss += __shfl_xor(ss, 8); ss += __shfl_xor(ss, 16);
        const float rstd = rsqrtf(ss * (1.f / 128.f) + EPS);
        r3.x = pk2(o[0] * rstd * w_ssd.x, o[1] * rstd * w_ssd.y); r3.y = pk2(o[2] * rstd * w_ssd.z, o[3] * rstd * w_ssd.w); }
      *(u32x2*)mr = r0; *(u32x2*)(mr + 256) = r1; *(u32x2*)(mr + 512) = r2; *(u32x2*)(mr + 768) = r3;
    }
  }
}

__global__ void __launch_bounds__(512) fwd_mega(Params p) {
  cg::grid_group grid = cg::this_grid();
  extern __shared__ __attribute__((aligned(16))) unsigned char lds[];
  PG8_LAS unsigned char* ldsl = (PG8_LAS unsigned char*)lds;
  int* slot = (int*)lds;
#ifdef X_REP_ALL
  unsigned* ctr0 = (unsigned*)(p.ws + WS_CTR);
#else
  unsigned* ctr = (unsigned*)(p.ws + WS_CTR);
#endif
  const bf16_t* Hb = (const bf16_t*)(p.ws + WS_H);
  bf16_t* Pb = (bf16_t*)(p.ws + WS_P);
  float* Xb = (float*)(p.ws + WS_X);
  const float* mod = (const float*)(p.ws + WS_MOD);

  volatile XLAS unsigned* xst = (volatile XLAS unsigned*)(ldsl + 147456 - 16);
  if (threadIdx.x == 0) { xst[0] = 0u; xst[1] = 0u; }
  __syncthreads();
  phase0(p, lds + 64);
  grid.sync();
  const XcdBarrier xb = xcd_barrier_post((unsigned*)(p.ws + WS_BAR), xst);
#ifdef X_REP_XB
  for (int i = 0; i < 40; ++i) xcd_barrier(xb);
#endif
  for (int layer = 0; layer < NL; ++layer) {
#ifdef X_REP_ALL
    for (int rep = 0; rep < 2; ++rep) {
    unsigned* ctr = ctr0 + rep * 32;
#endif
    if (layer == 0) convert_weights(p, layer, lds + 64);
    norm_phase(p, layer, 0);
    xcd_barrier(xb);
    { pg8::Gemm g{Hb, (const bf16_t*)(p.ws + (size_t)(layer & 1) * WBUF + WS_WIN), T, NP, D}; pg8::StaticOrder S; S.init(T, NP, gridDim.x, blockIdx.x);
      EpiP E{Pb, (float*)(p.ws + WS_GATE)}; pg8::gemm_phase<EpiP, pg8::StaticOrder>(ldsl, g, S, E, nullptr); }
    xcd_barrier(xb);
    { unsigned* q = ctr + layer * 16;
      if (blockIdx.x < 96) {
        const int id = blockIdx.x;
        const int mixer = id >> 5, rem = id & 31, seq = 32 + (rem >> 3), head = (rem >> 1) & 3, dir = rem & 1;
        if (mixer == 0) gdn_task(p, layer, seq, head, dir, lds);
        if (mixer == 1) decay_task<true>(p, layer, seq, head, dir, lds);
        if (mixer == 2) decay_task<false>(p, layer, seq, head, dir, lds);
      }
      const int s0 = (blockIdx.x >> 4) % 5;
      for (int i = 0; i < 5; ++i) {
        const int ty = (s0 + i) % 5;
        const int cnt = ty == 4 ? (layer + 1 < NL ? CV_ALL / 8 : 0) : 256;
        for (;;) {
          const int id = next_task(q + 2 + ty, slot);
          if (id >= cnt) break;
          if (ty == 0) {
            hy1_task(p, layer, id, lds);
            __threadfence(); __syncthreads();
            if (threadIdx.x == 0) __hip_atomic_fetch_add(q + 1, 1u, __ATOMIC_RELEASE, __HIP_MEMORY_SCOPE_AGENT);
          } else if (ty == 4) {
            convert_item4(p, layer + 1, id * 8, (float*)(lds + 64)); convert_item4(p, layer + 1, id * 8 + 4, (float*)(lds + 64));
          } else {
            const int seq = id >> 3, head = (id >> 1) & 3, dir = id & 1;
            if (ty == 1) gdn_task(p, layer, seq, head, dir, lds);
            if (ty == 2) decay_task<true>(p, layer, seq, head, dir, lds);
            if (ty == 3) decay_task<false>(p, layer, seq, head, dir, lds);
          }
        }
      }
      if (threadIdx.x == 0) { while (__hip_atomic_load(q + 1, __ATOMIC_ACQUIRE, __HIP_MEMORY_SCOPE_AGENT) < 256u) __builtin_amdgcn_s_sleep(8); }
      __syncthreads(); __threadfence();
      for (;;) { const int id = next_task(q + 7, slot); if (id >= 256) break; hy2_task<true>(p, layer, id, lds); }
      for (;;) { const int id = next_task(q + 8, slot); if (id >= 256) break; hy2_task<false>(p, layer, id, lds); }
    }
    xcd_barrier(xb);
    finalize_rows(p, layer, lds);
    xcd_barrier(xb);
#ifdef X_REP_ALL
    }
#endif
    { pg8::Gemm g{(const bf16_t*)(p.ws + WS_MIX), (const bf16_t*)(p.ws + (size_t)(layer & 1) * WBUF + WS_WOUT), T, D, D}; pg8::StaticOrder S; S.init(T, D, gridDim.x, blockIdx.x);
      EpiRes E{layer == 0 ? p.x_prompt : Xb, layer == 0 ? p.x_sample : Xb + (size_t)TP * D, Xb, mod + (size_t)layer * 5 * 6144 + 2048};
      pg8::gemm_phase<EpiRes, pg8::StaticOrder>(ldsl, g, S, E, nullptr);
#if defined(X_REP_G24) || defined(X_REP_ALL)
      EpiRes E2 = E; E2.xout = (float*)(p.ws + WS_P); pg8::gemm_phase<EpiRes, pg8::StaticOrder>(ldsl, g, S, E2, nullptr);
#endif
    }
    xcd_barrier(xb);
#ifdef X_REP_ALL
    for (int rep2 = 0; rep2 < 2; ++rep2) {
#endif
    norm_phase(p, layer, 1);
    xcd_barrier(xb);
    { pg8::Gemm g{Hb, (const bf16_t*)(p.ws + (size_t)(layer & 1) * WBUF + WS_W1), T, 4096, D}; pg8::StaticOrder S; S.init(T, 4096, gridDim.x, blockIdx.x);
      EpiRelu2 E{Pb}; pg8::gemm_phase<EpiRelu2, pg8::StaticOrder>(ldsl, g, S, E, nullptr); }
    xcd_barrier(xb);
#ifdef X_REP_ALL
    }
#endif
    { pg8::Gemm g{Pb, (const bf16_t*)(p.ws + (size_t)(layer & 1) * WBUF + WS_W2), T, D, 4096}; pg8::StaticOrder S; S.init(T, D, gridDim.x, blockIdx.x);
      EpiRes E{Xb, Xb + (size_t)TP * D, Xb, mod + (size_t)layer * 5 * 6144 + 5120};
#if defined(X_REP_G24) || defined(X_REP_ALL)
      { EpiRes E2 = E; E2.xout = (float*)(p.ws + WS_MIX); pg8::gemm_phase<EpiRes, pg8::StaticOrder>(ldsl, g, S, E2, nullptr); }
#endif
      pg8::gemm_phase<EpiRes, pg8::StaticOrder>(ldsl, g, S, E, nullptr); }
    xcd_barrier(xb);
  }
  final_norm(p);
}

extern "C" void kernel_launch(void* const* d_in, const int* in_sizes, int n_in, void* d_out, int out_size,
                              void* d_ws, size_t ws_size, hipStream_t stream) {
  constexpr size_t kDynLds = 144 * 1024;
  static int grid_blocks = 0;
  if (!grid_blocks) {
    int dev = 0, cus = 0, per_cu = 0;
    (void)hipGetDevice(&dev);
    (void)hipDeviceGetAttribute(&cus, hipDeviceAttributeMultiprocessorCount, dev);
    (void)hipFuncSetAttribute((const void*)fwd_mega, hipFuncAttributeMaxDynamicSharedMemorySize, (int)kDynLds);
    (void)hipOccupancyMaxActiveBlocksPerMultiprocessor(&per_cu, (const void*)fwd_mega, 512, kDynLds);
    grid_blocks = cus > 0 ? cus : 256;
    if (n_in != 38 || ws_size < WS_END || out_size != 33554432) { fprintf(stderr, "kernel_launch: unexpected sizes n_in %d ws %zu out %d\n", n_in, ws_size, out_size); grid_blocks = -1; }
  }
  if (grid_blocks < 0) return;
  Params p{};
  const float** pp = (const float**)&p;
  for (int i = 0; i < 38; ++i) pp[i] = (const float*)d_in[i];
  p.out = (float*)d_out; p.ws = (unsigned char*)d_ws;
  void* args[] = {&p};
  hipError_t e = hipLaunchCooperativeKernel((const void*)fwd_mega, dim3(grid_blocks), dim3(512), args, kDynLds, stream);
  if (e != hipSuccess) fprintf(stderr, "cooperative launch failed: %s (grid %d)\n", hipGetErrorString(e), grid_blocks);
}
```

```cpp
#include <hip/hip_runtime.h>
#include <hip/hip_cooperative_groups.h>
#include <cstdio>
namespace cg = cooperative_groups;
namespace pg8 {
#define PG8_LAS __attribute__((address_space(3)))
typedef unsigned short bf16_t;
typedef short bf16x8 __attribute__((ext_vector_type(8)));
typedef float f32x4 __attribute__((ext_vector_type(4)));
typedef unsigned u32x4 __attribute__((ext_vector_type(4)));
constexpr int BM = 256, BK = 64, HALF = 128, HTB = HALF * BK * 2  , STAGE_BYTES = 8 * HTB, NXCD = 8, WGM = 8;

__host__ __device__ __forceinline__ int lds_byte(int r, int c) { const int st = (r >> 4) * 2 + (c >> 5), rr = r & 15, cc = c & 31, ob = rr * 64 + cc * 2; return st * 1024 + (ob ^ (((ob >> 9) & 1) << 5)); }
__host__ __device__ __forceinline__ void stage_rc(int b, int& R, int& C) { const int st = b / 1024, sb = b % 1024, swz = sb ^ (((sb >> 9) & 1) << 5); R = (st >> 1) * 16 + swz / 64; C = (st & 1) * 32 + (swz % 64) / 2; }
__host__ __device__ __forceinline__ int perm32(int rho) { const int n = rho >> 4, i = rho & 15; return 8 * (i >> 2) + 4 * n + (i & 3); }

struct Unit { int pm, pn; };
struct Gemm { const bf16_t* A; const bf16_t* Bt; int M, N, K; };

struct StaticOrder {
    int nM, nN, nwg, G, c;
    __host__ __device__ void init(int M, int N, int G_, int c_) { nM = M / BM; nN = N / BM; nwg = nM * nN; G = G_; c = c_; }
    __host__ __device__ bool next(int i, Unit& u) const {
        const long L = (long)i * G + c; if (L >= nwg) return false;
        int wgid = (int)L; { const int q = nwg / NXCD, r = nwg % NXCD, xcd = wgid % NXCD, off = wgid / NXCD; wgid = (xcd < r ? xcd * (q + 1) : r * (q + 1) + (xcd - r) * q) + off; }
        const int nig = WGM * nN, gid = wgid / nig, fm = gid * WGM, gsz = (nM - fm) < WGM ? (nM - fm) : WGM;
        u.pm = fm + ((wgid % nig) % gsz); u.pn = (wgid % nig) / gsz; return true;
    }
    __device__ __forceinline__ void a_ready(const Unit&) const {}
    __device__ __forceinline__ void done(const Unit&) const {}
};
__device__ __forceinline__ unsigned cvt_pk_bf16(float lo, float hi) { unsigned r; asm volatile("v_cvt_pk_bf16_f32 %0, %1, %2" : "=v"(r) : "v"(lo), "v"(hi)); return r; }

template <class Epi, class Sched, bool STAMP = false>
__device__ __forceinline__ void gemm_phase(PG8_LAS unsigned char* lds, const Gemm g, const Sched& S, const Epi& E, unsigned long long* stamps) {
    int tid_l = threadIdx.x; asm volatile("" : "+v"(tid_l));
    const int tid = tid_l, wid = __builtin_amdgcn_readfirstlane(tid >> 6), lane = tid & 63, wr = wid >> 2, wc = wid & 3, fr = lane & 15, fq = lane >> 4;
    const int K = g.K, nt = K / BK;
    int ts_lo = 0, ts_hi = 0, nts = 0; const unsigned long long rt_entry = STAMP ? (unsigned long long)wall_clock64() : 0ull;
#define PG8_STAMP() do { if (STAMP && wid == 0 && nts < 64) { const unsigned long long _c = (unsigned long long)clock64(); \
        ts_lo = (lane == nts) ? (int)(unsigned)_c : ts_lo; ts_hi = (lane == nts) ? (int)(unsigned)(_c >> 32) : ts_hi; ++nts; } } while (0)
    PG8_STAMP();
    unsigned voffA[2], voffB[2];
#pragma unroll
    for (int i = 0; i < 2; ++i) { int R, C; stage_rc(tid * 16 + i * 8192, R, C); const int Rb = Epi::PERM ? ((R & ~31) + perm32(R & 31)) : R;
        voffA[i] = (unsigned)(R * K + C) * 2u; voffB[i] = (unsigned)(Rb * K + C) * 2u; }
    const size_t kstep = (size_t)(BK * 2);
    const size_t hstep = (size_t)HALF * K * 2;
    const size_t tstep = 2 * hstep;
    const unsigned ldsw = (unsigned)wid * 1024u;
    const int aoff = lds_byte(wr * 64 + fr, fq * 8), boff = lds_byte(wc * 32 + fr, fq * 8);
#define PG8_SA(b, h) (((b) * 2 + (h)) * HTB)
#define PG8_SB(b, h) ((4 + (b) * 2 + (h)) * HTB)
#define PG8_STAGE(bufoff, gbase, voff) do { _Pragma("unroll") for (int _i = 0; _i < 2; ++_i) \
        __builtin_amdgcn_global_load_lds((const unsigned*)((const char*)(gbase) + (voff)[_i]), (PG8_LAS unsigned*)(lds + (bufoff) + ldsw + _i * 8192), 16, 0, 0); } while (0)
#define PG8_LDA(dst, b, h) do { _Pragma("unroll") for (int m = 0; m < 4; ++m) _Pragma("unroll") for (int k = 0; k < 2; ++k) dst[m][k] = *(const PG8_LAS bf16x8*)(lds + PG8_SA(b, h) + aoff + m * 2048 + k * 1024); } while (0)
#define PG8_LDB(dst, b, h) do { _Pragma("unroll") for (int n = 0; n < 2; ++n) _Pragma("unroll") for (int k = 0; k < 2; ++k) dst[n][k] = *(const PG8_LAS bf16x8*)(lds + PG8_SB(b, h) + boff + n * 2048 + k * 1024); } while (0)
#define PG8_MMA(ai, bj, At, Bt) do { __builtin_amdgcn_s_setprio(1); _Pragma("unroll") for (int m = 0; m < 4; ++m) _Pragma("unroll") for (int n = 0; n < 2; ++n) _Pragma("unroll") for (int k = 0; k < 2; ++k) \
        acc[ai][bj][m][n] = __builtin_amdgcn_mfma_f32_16x16x32_bf16(Bt[n][k], At[m][k], acc[ai][bj][m][n], 0, 0, 0); __builtin_amdgcn_s_setprio(0); } while (0)
#define PG8_WAIT_V(n) asm volatile("s_waitcnt vmcnt(" #n ")" ::: "memory")
#define PG8_WAIT_L(n) asm volatile("s_waitcnt lgkmcnt(" #n ")" ::: "memory")
#define PG8_BAR __builtin_amdgcn_s_barrier()
#define PG8_SCHED __builtin_amdgcn_sched_barrier(0)
    Unit cur, nxt; int ui = 0;
    if (!S.next(0, cur)) return;
    f32x4 acc[2][2][4][2];
#pragma unroll
    for (int a = 0; a < 2; ++a)
#pragma unroll
        for (int b = 0; b < 2; ++b)
#pragma unroll
            for (int m = 0; m < 4; ++m)
#pragma unroll
                for (int n = 0; n < 2; ++n) acc[a][b][m][n] = (f32x4){0.f, 0.f, 0.f, 0.f};
    bf16x8 At[4][2], B0[2][2], B1[2][2];
    const char* cA = (const char*)g.A + (size_t)cur.pm * tstep; const char* cB = (const char*)g.Bt + (size_t)cur.pn * tstep;
    S.a_ready(cur);
    PG8_STAGE(PG8_SB(0, 0), cB, voffB); PG8_STAGE(PG8_SA(0, 0), cA, voffA); PG8_STAGE(PG8_SB(0, 1), cB + hstep, voffB); PG8_STAGE(PG8_SA(0, 1), cA + hstep, voffA);
    if (wr == 1) PG8_BAR;
    PG8_WAIT_V(4); PG8_BAR;
    PG8_STAGE(PG8_SB(1, 0), cB + kstep, voffB); PG8_STAGE(PG8_SA(1, 0), cA + kstep, voffA); PG8_STAGE(PG8_SB(1, 1), cB + hstep + kstep, voffB);
    PG8_WAIT_V(6); PG8_BAR;
    PG8_STAMP();
    for (;;) {
        const bool has_next = S.next(ui + 1, nxt);
        const char* nA = has_next ? (const char*)g.A + (size_t)nxt.pm * tstep : cA; const char* nB = has_next ? (const char*)g.Bt + (size_t)nxt.pn * tstep : cB;
        for (int t = 0; t < nt; t += 2) {
            const bool last = (t == nt - 2);
            const char* a1 = cA + (size_t)(t + 1) * kstep;
            const char* a2 = last ? nA : cA + (size_t)(t + 2) * kstep; const char* b2 = last ? nB : cB + (size_t)(t + 2) * kstep;
            const char* a3 = a2 + kstep; const char* b3 = b2 + kstep;
            if (last && has_next) S.a_ready(nxt);
            PG8_LDB(B0, 0, 0); PG8_SCHED; PG8_LDA(At, 0, 0); PG8_STAGE(PG8_SA(1, 1), a1 + hstep, voffA);
            PG8_WAIT_L(8); PG8_BAR; PG8_WAIT_L(0); PG8_MMA(0, 0, At, B0); PG8_BAR; PG8_SCHED;
            PG8_LDB(B1, 0, 1); PG8_STAGE(PG8_SB(0, 0), b2, voffB);
            PG8_BAR; PG8_WAIT_L(0); PG8_MMA(0, 1, At, B1); PG8_BAR;
            PG8_LDA(At, 0, 1); PG8_STAGE(PG8_SA(0, 0), a2, voffA);
            PG8_BAR; PG8_WAIT_L(0); PG8_MMA(1, 0, At, B0); PG8_BAR; PG8_SCHED;
            PG8_STAGE(PG8_SB(0, 1), b2 + hstep, voffB);
            PG8_WAIT_V(6); PG8_BAR; PG8_MMA(1, 1, At, B1); PG8_BAR;
            PG8_LDB(B0, 1, 0); PG8_SCHED; PG8_LDA(At, 1, 0); PG8_STAGE(PG8_SA(0, 1), a2 + hstep, voffA);
            PG8_WAIT_L(8); PG8_BAR; PG8_WAIT_L(0); PG8_MMA(0, 0, At, B0); PG8_BAR; PG8_SCHED;
            PG8_LDB(B1, 1, 1); PG8_STAGE(PG8_SB(1, 0), b3, voffB);
            PG8_BAR; PG8_WAIT_L(0); PG8_MMA(0, 1, At, B1); PG8_BAR;
            PG8_LDA(At, 1, 1); PG8_STAGE(PG8_SA(1, 0), a3, voffA);
            PG8_BAR; PG8_WAIT_L(0); PG8_MMA(1, 0, At, B0); PG8_BAR; PG8_SCHED;
            PG8_STAGE(PG8_SB(1, 1), b3 + hstep, voffB);
            PG8_WAIT_V(6); PG8_BAR; PG8_MMA(1, 1, At, B1); PG8_BAR;
        }
        PG8_STAMP();
        if constexpr (!Epi::AFTER_DRAIN) { E(acc, cur, wr, wc, fr, fq); S.done(cur); }
        PG8_STAMP();
        if (!has_next) break;
#pragma unroll
        for (int a = 0; a < 2; ++a)
#pragma unroll
            for (int b = 0; b < 2; ++b)
#pragma unroll
                for (int m = 0; m < 4; ++m)
#pragma unroll
                    for (int n = 0; n < 2; ++n) acc[a][b][m][n] = (f32x4){0.f, 0.f, 0.f, 0.f};
        cur = nxt; cA = nA; cB = nB; ++ui;
    }
    PG8_WAIT_V(0);
    if (wr == 0) PG8_BAR;
    PG8_BAR;
    if constexpr (Epi::AFTER_DRAIN) { E.fused(acc, cur, wr, wc, fr, fq, lds, wid, lane); S.done(cur); }
    PG8_STAMP();
    if (STAMP && wid == 0) { stamps[lane] = lane < nts ? (((unsigned long long)(unsigned)ts_hi << 32) | (unsigned)ts_lo) : 0ull;
        if (lane == 62) stamps[62] = rt_entry; if (lane == 63) stamps[63] = (unsigned long long)wall_clock64(); }
#undef PG8_STAMP
#undef PG8_SA
#undef PG8_SB
#undef PG8_STAGE
#undef PG8_LDA
#undef PG8_LDB
#undef PG8_MMA
#undef PG8_WAIT_V
#undef PG8_WAIT_L
#undef PG8_BAR
#undef PG8_SCHED
}
}
#define XB_TMO      128
#define XB_XCNT(j)  (256  + 64 * (j))
#define XB_XSUB(j)  (1280 + 64 * (j))
#define XB_XGEN(j)  (2304 + 64 * (j))
#define XB_TOP      3328
#define XB_TOPGEN   3392
#define XCD_BAR_WORDS 3456
#define XB_SPIN_CAP (1u << 22)
#define XLAS __attribute__((address_space(3)))

__device__ __forceinline__ unsigned xb_ld(unsigned* p)              { return __hip_atomic_load(p, __ATOMIC_RELAXED, __HIP_MEMORY_SCOPE_AGENT); }
__device__ __forceinline__ unsigned xb_add(unsigned* p, unsigned v) { return __hip_atomic_fetch_add(p, v, __ATOMIC_RELAXED, __HIP_MEMORY_SCOPE_AGENT); }
__device__ __forceinline__ unsigned xb_xcc_id() { return (unsigned)__builtin_amdgcn_s_getreg((3 << 11) | 20) & 0xFu; }
#define XB_SPIN(cond, bar) do { unsigned _sp = 0; while (cond) { __builtin_amdgcn_s_sleep(1); \
    if ((++_sp & 255u) == 0u) { if (xb_ld(&(bar)[XB_TMO])) break; if (_sp > XB_SPIN_CAP) { atomicAdd(&(bar)[XB_TMO], 1u); break; } } } } while (0)

struct XcdBarrier {
    unsigned* bar; unsigned x;
    volatile XLAS unsigned* st;
};

__device__ __forceinline__ XcdBarrier xcd_barrier_post(unsigned* bar, volatile XLAS unsigned* st) {
    XcdBarrier b; b.bar = bar; b.x = xb_xcc_id(); b.st = st;
    if (threadIdx.x == 0) (void)xb_add(&bar[XB_XCNT(b.x)], 1u);
    return b;
}
__device__ __forceinline__ void xcd_barrier_complete(unsigned* bar, unsigned x, unsigned& nloc, unsigned& nx) {
    const unsigned G = gridDim.x * gridDim.y * gridDim.z;
    unsigned sum, cnt, mine, sp = 0u;
    for (;;) {
        sum = 0u; cnt = 0u; mine = 0u;
#pragma unroll
        for (unsigned j = 0; j < 16; ++j) { const unsigned c = xb_ld(&bar[XB_XCNT(j)]); sum += c; cnt += (c > 0u) ? 1u : 0u; mine = (j == x) ? c : mine; }
        if (sum == G) break;
        __builtin_amdgcn_s_sleep(1);
        if ((++sp & 255u) == 0u) { if (xb_ld(&bar[XB_TMO])) break; if (sp > XB_SPIN_CAP) { atomicAdd(&bar[XB_TMO], 1u); break; } }
    }
    nloc = mine > 0u ? mine : 1u; nx = cnt > 0u ? cnt : 1u;
}

__device__ __forceinline__ void xcd_barrier(const XcdBarrier& b) {
    asm volatile("s_waitcnt vmcnt(0)" ::: "memory");
    __syncthreads();
    if (threadIdx.x == 0) {
        unsigned* bar = b.bar;
        __builtin_amdgcn_s_waitcnt(0);
        unsigned nloc = b.st[0], nx = b.st[1];
        if (nloc == 0u) { xcd_barrier_complete(bar, b.x, nloc, nx); b.st[0] = nloc; b.st[1] = nx; }
        const unsigned old = xb_add(&bar[XB_XSUB(b.x)], 1u);
        const unsigned gen = old / nloc;
        if (old + 1u == (gen + 1u) * nloc) {
            __builtin_amdgcn_fence(__ATOMIC_RELEASE, "agent");
            asm volatile("s_waitcnt vmcnt(0)" ::: "memory");
            const unsigned og = xb_add(&bar[XB_TOP], 1u);
            const unsigned tg = og / nx;
            if (og + 1u == (tg + 1u) * nx) xb_add(&bar[XB_TOPGEN], 1u);
            else XB_SPIN(xb_ld(&bar[XB_TOPGEN]) == tg, bar);
            __builtin_amdgcn_fence(__ATOMIC_ACQUIRE, "agent");
            xb_add(&bar[XB_XGEN(b.x)], 1u);
            asm volatile("s_waitcnt vmcnt(0)" ::: "memory");
        } else {
            XB_SPIN(xb_ld(&bar[XB_XGEN(b.x)]) == gen, bar);
            __builtin_amdgcn_fence(__ATOMIC_ACQUIRE, "agent");
            asm volatile("s_waitcnt vmcnt(0)" ::: "memory");
        }
    }
    __syncthreads();
}


using pg8::bf16_t; using pg8::bf16x8; using pg8::f32x4; using pg8::u32x4;
typedef float f32x2v __attribute__((ext_vector_type(2)));
typedef unsigned u32x2 __attribute__((ext_vector_type(2)));

constexpr int T = 16384, TP = 8192, D = 1024, NP = 4096, NL = 4;
constexpr float EPS = 1e-6f;
constexpr int C_RQ = 0, C_RK = 256, C_RV = 512, C_RG = 768, C_HY = 1024;
constexpr int C_GQ = 1792, C_GK = 2048, C_GV = 2304, C_GZ = 2560;
constexpr int C_SX = 2832, C_SB = 3088, C_SC = 3344, C_SZ = 3600;
constexpr int INC = 3864;

constexpr size_t WS_CTR = 0;
constexpr size_t WS_BAR = 4096;
constexpr size_t WS_MOD = 4096 + 16384;
constexpr size_t WS_GATE = WS_MOD + 491520;
constexpr size_t WS_X = WS_GATE + (size_t)T * 32 * 4;
constexpr size_t WS_H = WS_X + (size_t)T * D * 4;
constexpr size_t WS_P = WS_H + (size_t)T * D * 2;
constexpr size_t WS_MIX = WS_P + (size_t)T * NP * 2;
constexpr size_t WS_OB = WS_MIX + (size_t)T * D * 2;
constexpr size_t WS_WIN = WS_OB + (size_t)T * D * 2;
constexpr size_t WS_WOUT = WS_WIN + 8388608;
constexpr size_t WS_W1 = WS_WOUT + 2097152;
constexpr size_t WS_W2 = WS_W1 + 8388608;
constexpr size_t WBUF = 27262976;
constexpr size_t WS_TAPS = WS_W2 + 8388608 + WBUF;
constexpr int GT_CH = 4640, GT_SOFF = 528;
constexpr int TS = T + 64;
constexpr size_t WS_U = WS_TAPS + (size_t)4 * 256 * GT_CH * 2;
constexpr size_t WS_X0 = WS_U + (size_t)TS * 256 * 2;
constexpr size_t WS_Y = WS_X0 + (size_t)TS * 256 * 2;
constexpr size_t WS_END = WS_Y + (size_t)TS * 256 * 2;

constexpr size_t OUT_RET = (size_t)T * D, OUT_GDN = OUT_RET + 4194304, OUT_SSD = OUT_GDN + 4194304;

struct Params {
  const float *x_prompt, *x_sample, *state_ret, *state_gdn, *state_ssd, *c, *c_ctx;
  const float *norm1_w, *norm2_w, *w_mod, *b_mod, *w_in, *w_out, *ret_log_decay, *ret_norm_w;
  const float *hy_conv_w, *hy_conv_b, *hy_freq, *hy_w1, *hy_b1, *hy_w2, *hy_b2, *hy_w3, *hy_bias, *hy_norm_w;
  const float *gdn_conv_w, *gdn_A_log, *gdn_dt_bias, *gdn_norm_w;
  const float *ssd_conv_w, *ssd_conv_b, *ssd_A_log, *ssd_dt_bias, *ssd_D, *ssd_norm_w;
  const float *mlp_w1, *mlp_w2, *final_norm_w;
  float* out; unsigned char* ws;
};

__device__ __forceinline__ float wave_sum(float v) {
#pragma unroll
  for (int o = 32; o >= 1; o >>= 1) v += __shfl_xor(v, o);
  return v;
}
__device__ __forceinline__ bf16_t f2bf(float f) { return __builtin_bit_cast(unsigned short, (__bf16)f); }
__device__ __forceinline__ float bf2f(bf16_t b) { return __uint_as_float(((unsigned)b) << 16); }
typedef __bf16 bf16x2_t __attribute__((ext_vector_type(2)));
__device__ __forceinline__ unsigned pk2(float lo, float hi) { const bf16x2_t v = {(__bf16)lo, (__bf16)hi}; return __builtin_bit_cast(unsigned, v); }
__device__ __forceinline__ float silu_f(float x) { return x * __builtin_amdgcn_rcpf(1.f + __expf(-x)); }
__device__ __forceinline__ float sigmoid_f(float x) { return __builtin_amdgcn_rcpf(1.f + __expf(-x)); }
__device__ __forceinline__ float softplus_f(float x) {
  if (x > 20.f) return x;
  const float e = __expf(x);
  return e < 0.01f ? e * (1.f - e * (0.5f - e * 0.33333334f)) : __logf(1.f + e);
}
__device__ __forceinline__ void ld8(const bf16_t* p, float (&o)[8]) {
  const u32x4 v = *(const u32x4*)p;
  o[0] = __uint_as_float(v.x << 16); o[1] = __uint_as_float(v.x & 0xffff0000u);
  o[2] = __uint_as_float(v.y << 16); o[3] = __uint_as_float(v.y & 0xffff0000u);
  o[4] = __uint_as_float(v.z << 16); o[5] = __uint_as_float(v.z & 0xffff0000u);
  o[6] = __uint_as_float(v.w << 16); o[7] = __uint_as_float(v.w & 0xffff0000u);
}
__device__ __forceinline__ void ldf8(const float* p, float (&o)[8]) {
  const f32x4 a = *(const f32x4*)p, b = *(const f32x4*)(p + 4);
  o[0] = a.x; o[1] = a.y; o[2] = a.z; o[3] = a.w; o[4] = b.x; o[5] = b.y; o[6] = b.z; o[7] = b.w;
}
__device__ __forceinline__ void st8bf(bf16_t* p, const float (&v)[8]) {
  u32x4 w; w.x = pk2(v[0], v[1]); w.y = pk2(v[2], v[3]); w.z = pk2(v[4], v[5]); w.w = pk2(v[6], v[7]);
  *(u32x4*)p = w;
}
__device__ __forceinline__ void conv8(const bf16_t* prow, int t, int L, const float* cw, const float* cb, float (&o)[8]) {
  float x[8], w[8];
  ld8(prow, x); ldf8(cw + 768, w);
  if (cb) { float b[8]; ldf8(cb, b);
#pragma unroll
    for (int e = 0; e < 8; ++e) o[e] = x[e] * w[e] + b[e];
  } else {
#pragma unroll
    for (int e = 0; e < 8; ++e) o[e] = x[e] * w[e];
  }
  if (t > 0) { ld8(prow - NP, x); ldf8(cw, w);
#pragma unroll
    for (int e = 0; e < 8; ++e) o[e] += x[e] * w[e]; }
  if (t < L - 1) { ld8(prow + NP, x); ldf8(cw + 1536, w);
#pragma unroll
    for (int e = 0; e < 8; ++e) o[e] += x[e] * w[e]; }
}
__device__ __forceinline__ void ld8v(u32x4 v, float (&o)[8]) {
  o[0] = __uint_as_float(v.x << 16); o[1] = __uint_as_float(v.x & 0xffff0000u); o[2] = __uint_as_float(v.y << 16); o[3] = __uint_as_float(v.y & 0xffff0000u);
  o[4] = __uint_as_float(v.z << 16); o[5] = __uint_as_float(v.z & 0xffff0000u); o[6] = __uint_as_float(v.w << 16); o[7] = __uint_as_float(v.w & 0xffff0000u); }
__device__ __forceinline__ void conv8b(const bf16_t* prow, int t, int L, const float* cw, const float* cb, float (&o)[8]) {
  const int dm = t > 0 ? -NP : 0, dp = t < L - 1 ? NP : 0;
  const float m0 = t > 0 ? 1.f : 0.f, m2 = t < L - 1 ? 1.f : 0.f;
  const u32x4 r0 = *(const u32x4*)(prow + dm), r1 = *(const u32x4*)prow, r2 = *(const u32x4*)(prow + dp);
  float x0[8], x1[8], x2[8], w0[8], w1[8], w2[8], b[8];
  ldf8(cw, w0); ldf8(cw + 768, w1); ldf8(cw + 1536, w2); ldf8(cb, b);
  ld8v(r0, x0); ld8v(r1, x1); ld8v(r2, x2);
#pragma unroll
  for (int e = 0; e < 8; ++e) o[e] = b[e] + x1[e] * w1[e] + m0 * (x0[e] * w0[e]) + m2 * (x2[e] * w2[e]);
}
__device__ __forceinline__ f32x4 mma_tile(const bf16_t* A, int lda, const bf16_t* Bt, int ldb, int K, f32x4 acc, int lane, int xa = 0, int xb = 0) {
  const bf16_t* ap = A + (lane & 15) * lda;
  const bf16_t* bp = Bt + (lane & 15) * ldb;
  const int kq = (lane >> 4) * 8;
  for (int k0 = 0; k0 < K; k0 += 32) {
    const bf16x8 a = *(const bf16x8*)(ap + ((k0 + kq) ^ xa)), b = *(const bf16x8*)(bp + ((k0 + kq) ^ xb));
    acc = __builtin_amdgcn_mfma_f32_16x16x32_bf16(a, b, acc, 0, 0, 0);
  }
  return acc;
}
__device__ __forceinline__ int next_task(unsigned* ctr, int* slot) {
  __syncthreads();
  if (threadIdx.x == 0) *slot = (int)atomicAdd(ctr, 1u);
  __syncthreads();
  return *(volatile int*)slot;
}
__device__ __forceinline__ const float* xrow_ptr(const Params& p, int layer, int row) {
  if (layer == 0) return row < TP ? p.x_prompt + (size_t)row * D : p.x_sample + (size_t)(row - TP) * D;
  return (const float*)(p.ws + WS_X) + (size_t)row * D;
}
__device__ __forceinline__ int cond_row(int row) { return row < TP ? 0 : 1 + ((row - TP) >> 11); }

struct EpiP {
  static constexpr bool PERM = true, AFTER_DRAIN = false;
  bf16_t* O; float* gates;
  __device__ __forceinline__ void operator()(const f32x4 (&acc)[2][2][4][2], const pg8::Unit& u, int wr, int wc, int fr, int fq) const {
    const int row0 = u.pm * 256 + wr * 64 + fr, col0 = u.pn * 256 + wc * 32 + 8 * fq;
#pragma unroll
    for (int ai = 0; ai < 2; ++ai)
#pragma unroll
      for (int m = 0; m < 4; ++m) {
        const int row = row0 + ai * 128 + m * 16;
#pragma unroll
        for (int bj = 0; bj < 2; ++bj) {
          const int col = col0 + bj * 128;
          const f32x4 v0 = acc[ai][bj][m][0], v1 = acc[ai][bj][m][1];
          u32x4 w; w.x = pk2(v0[0], v0[1]); w.y = pk2(v0[2], v0[3]); w.z = pk2(v1[0], v1[1]); w.w = pk2(v1[2], v1[3]);
          *(u32x4*)(O + (size_t)row * NP + col) = w;
          if (col >= 2816 && col < 2832) { float* g = gates + (size_t)row * 32 + (col - 2816); *(f32x4*)g = v0; *(f32x4*)(g + 4) = v1; }
          if (col == 3856) { float* g = gates + (size_t)row * 32 + 16; *(f32x4*)g = v0; *(f32x4*)(g + 4) = v1; }
        }
      }
  }
};
struct EpiRelu2 {
  static constexpr bool PERM = true, AFTER_DRAIN = false;
  bf16_t* O;
  __device__ __forceinline__ void operator()(const f32x4 (&acc)[2][2][4][2], const pg8::Unit& u, int wr, int wc, int fr, int fq) const {
    const int row0 = u.pm * 256 + wr * 64 + fr, col0 = u.pn * 256 + wc * 32 + 8 * fq;
#pragma unroll
    for (int ai = 0; ai < 2; ++ai)
#pragma unroll
      for (int m = 0; m < 4; ++m) {
        const int row = row0 + ai * 128 + m * 16;
#pragma unroll
        for (int bj = 0; bj < 2; ++bj) {
          const int col = col0 + bj * 128;
          f32x4 v0 = acc[ai][bj][m][0], v1 = acc[ai][bj][m][1];
#pragma unroll
          for (int j = 0; j < 4; ++j) { const float a = fmaxf(v0[j], 0.f), b = fmaxf(v1[j], 0.f); v0[j] = a * a; v1[j] = b * b; }
          u32x4 w; w.x = pk2(v0[0], v0[1]); w.y = pk2(v0[2], v0[3]); w.z = pk2(v1[0], v1[1]); w.w = pk2(v1[2], v1[3]);
          *(u32x4*)(O + (size_t)row * NP + col) = w;
        }
      }
  }
};
struct EpiRes {
  static constexpr bool PERM = false, AFTER_DRAIN = false;
  const float* xin_p; const float* xin_s; float* xout; const float* gate;
  __device__ __forceinline__ void operator()(const f32x4 (&acc)[2][2][4][2], const pg8::Unit& u, int wr, int wc, int fr, int fq) const {
    const int row0 = u.pm * 256 + wr * 64 + fr, col0 = u.pn * 256 + wc * 32 + 4 * fq;
    const float* gr = gate + (size_t)cond_row(u.pm * 256) * 6144 + col0;
    const float* xi0 = (u.pm * 256 < TP ? xin_p + (size_t)row0 * D : xin_s + (size_t)(row0 - TP) * D) + col0;
    float* xo0 = xout + (size_t)row0 * D + col0;
    f32x4 gv[2][2];
#pragma unroll
    for (int bj = 0; bj < 2; ++bj)
#pragma unroll
      for (int n = 0; n < 2; ++n) gv[bj][n] = *(const f32x4*)(gr + bj * 128 + n * 16);
    f32x4 xv[2][2][2];
#pragma unroll
    for (int bj = 0; bj < 2; ++bj)
#pragma unroll
      for (int n = 0; n < 2; ++n) xv[0][bj][n] = *(const f32x4*)(xi0 + bj * 128 + n * 16);
#pragma unroll
    for (int s = 0; s < 8; ++s) {
      const int ai = s >> 2, mm = s & 3;
      if (s < 7) { const int s1 = s + 1; const size_t off1 = (size_t)((s1 >> 2) * 128 + (s1 & 3) * 16) * D;
#pragma unroll
        for (int bj = 0; bj < 2; ++bj)
#pragma unroll
          for (int n = 0; n < 2; ++n) xv[(s + 1) & 1][bj][n] = *(const f32x4*)(xi0 + off1 + bj * 128 + n * 16); }
      const size_t off = (size_t)(ai * 128 + mm * 16) * D;
#pragma unroll
      for (int bj = 0; bj < 2; ++bj)
#pragma unroll
        for (int n = 0; n < 2; ++n) *(f32x4*)(xo0 + off + bj * 128 + n * 16) = xv[s & 1][bj][n] + gv[bj][n] * acc[ai][bj][mm][n];
    }
  }
};

__device__ __forceinline__ void phase0(const Params& p, unsigned char* lds) {
  int tid_l = threadIdx.x; asm volatile("" : "+v"(tid_l));
  const int tid = tid_l;
  float* mod = (float*)(p.ws + WS_MOD);
  if (blockIdx.x == 0) { if (tid < 64) ((unsigned*)(p.ws + WS_CTR))[tid] = 0u; for (int i = tid; i < XCD_BAR_WORDS; i += 512) ((unsigned*)(p.ws + WS_BAR))[i] = 0u; }
  float* sF = (float*)lds;
  constexpr int NMOD = NL * 48, NTAP = NL * 288;
  for (int task = blockIdx.x; task < NMOD + NTAP; task += gridDim.x) {
    __syncthreads();
    if (task < NMOD) {
      const int l = task / 48, cb = task % 48;
      float* sC = sF;
      float* sR = sF + 5120;
      for (int i = tid; i < 5120; i += 512) { const int r = i >> 10, k = i & 1023; const float v = (r == 0) ? p.c_ctx[k] : p.c[(r - 1) * 1024 + k]; sC[i] = silu_f(v); }
      __syncthreads();
      const int col = cb * 128 + (tid & 127), kq = tid >> 7;
      float a0 = 0.f, a1 = 0.f, a2 = 0.f, a3 = 0.f, a4 = 0.f;
      const float* wp = p.w_mod + ((size_t)l * 1024 + kq * 256) * 6144 + col;
#pragma unroll 8
      for (int k = 0; k < 256; ++k) {
        const float w = wp[(size_t)k * 6144]; const int kk = kq * 256 + k;
        a0 += sC[kk] * w; a1 += sC[1024 + kk] * w; a2 += sC[2048 + kk] * w; a3 += sC[3072 + kk] * w; a4 += sC[4096 + kk] * w;
      }
      float* rr = sR + kq * 640 + (tid & 127);
      rr[0] = a0; rr[128] = a1; rr[256] = a2; rr[384] = a3; rr[512] = a4;
      __syncthreads();
      if (tid < 128) {
        const float b = p.b_mod[l * 6144 + col];
#pragma unroll
        for (int r = 0; r < 5; ++r) mod[((size_t)l * 5 + r) * 6144 + col] = sR[r * 128 + tid] + sR[640 + r * 128 + tid] + sR[1280 + r * 128 + tid] + sR[1920 + r * 128 + tid] + b;
      }
    } else {
      const int tt = task - NMOD, l = tt / 288, g = tt % 288;
      const int L = g < 32 ? 256 : 2048, i0 = g < 32 ? g * 8 : (g - 32) * 8;
      float* sZ = sF;
      float* sH1 = sF + 288;
      float* sH2 = sF + 288 + 512;
      const int r8 = tid >> 6, j = tid & 63, i = i0 + r8;
      const float tn = (float)i / (float)(L - 1);
      if (j < 33) {
        float z;
        if (j == 0) z = tn;
        else {
          const int b = (j - 1) & 15;
          const float f = 1e-4f + (float)b * ((15.0f - 1e-4f) / 15.0f);
          const float wang = 6.283185307179586f * (float)i / (float)L;
          z = (j <= 16) ? cosf(f * wang) : -sinf(f * wang);
        }
        sZ[r8 * 36 + j] = z;
      }
      __syncthreads();
      const float fr = p.hy_freq[l * 64 + j];
      { float a = p.hy_b1[l * 64 + j];
        for (int e = 0; e < 33; ++e) a += sZ[r8 * 36 + e] * p.hy_w1[(l * 33 + e) * 64 + j];
        sH1[r8 * 64 + j] = sinf(fr * a); }
      __syncthreads();
      { float a = p.hy_b2[l * 64 + j];
        for (int e = 0; e < 64; ++e) a += sH1[r8 * 64 + e] * p.hy_w2[(l * 64 + e) * 64 + j];
        sH2[r8 * 64 + j] = sinf(fr * a); }
      __syncthreads();
      float acc[8];
#pragma unroll
      for (int r = 0; r < 8; ++r) acc[r] = 0.f;
      for (int e = 0; e < 64; ++e) {
        const float w = p.hy_w3[(l * 64 + e) * 512 + tid];
#pragma unroll
        for (int r = 0; r < 8; ++r) acc[r] += sH2[r * 64 + e] * w;
      }
      const int dir = tid >> 8, c = tid & 255;
      const float delta = 3.0701134573253944f + (float)c * ((15.350567286626973f - 3.0701134573253944f) / 255.0f);
      bf16_t* Gc = (bf16_t*)(p.ws + WS_TAPS) + ((size_t)l * 256 + c) * GT_CH + (L == 256 ? 0 : GT_SOFF);
#pragma unroll
      for (int r = 0; r < 8; ++r) {
        const int ii = i0 + r; const float tnr = (float)ii / (float)(L - 1);
        const float v = acc[r] * expf(-tnr * delta);
        if (dir == 0) Gc[L - ii] = f2bf(v);
        else if (ii >= 1) Gc[L + ii] = f2bf(v);
      }
    }
  }
}

constexpr int CV_IN = 16 * 64, CV_OUT = 16 * 16, CV_1 = 16 * 64, CV_2 = 64 * 16, CV_ALL = CV_IN + CV_OUT + CV_1 + CV_2;
__device__ __forceinline__ void convert_item4(const Params& p, int layer, int it0, float* sT) {
  unsigned char* wb = p.ws + (size_t)(layer & 1) * WBUF;
  const float* W; bf16_t* WT; int K, N, ntn, r = it0;
  if (r < CV_IN) { W = p.w_in + (size_t)layer * 1024 * INC; K = 1024; N = INC; WT = (bf16_t*)(wb + WS_WIN); ntn = 64; }
  else if ((r -= CV_IN) < CV_OUT) { W = p.w_out + (size_t)layer * 1024 * 1024; K = 1024; N = 1024; WT = (bf16_t*)(wb + WS_WOUT); ntn = 16; }
  else if ((r -= CV_OUT) < CV_1) { W = p.mlp_w1 + (size_t)layer * 1024 * 4096; K = 1024; N = 4096; WT = (bf16_t*)(wb + WS_W1); ntn = 64; }
  else { r -= CV_1; W = p.mlp_w2 + (size_t)layer * 4096 * 1024; K = 4096; N = 1024; WT = (bf16_t*)(wb + WS_W2); ntn = 16; }
  int tid_l = threadIdx.x; asm volatile("" : "+v"(tid_l));
  const int tid = tid_l;
  __syncthreads();
#pragma unroll
  for (int q = 0; q < 4; ++q) {
    const int tile = r + q, k0 = (tile / ntn) * 64, n0 = (tile % ntn) * 64;
#pragma unroll
    for (int i = 0; i < 8; ++i) {
      const int e = tid + i * 512, kk = e >> 6, nn = e & 63;
      sT[q * 4160 + kk * 65 + nn] = (n0 + nn < N) ? W[(size_t)(k0 + kk) * N + n0 + nn] : 0.f;
    }
  }
  __syncthreads();
  const int n = tid >> 3, kc = (tid & 7) * 8;
#pragma unroll
  for (int q = 0; q < 4; ++q) {
    const int tile = r + q, k0 = (tile / ntn) * 64, n0 = (tile % ntn) * 64;
    float v[8];
#pragma unroll
    for (int e = 0; e < 8; ++e) v[e] = sT[q * 4160 + (kc + e) * 65 + n];
    st8bf(WT + (size_t)(n0 + n) * K + k0 + kc, v);
  }
}
__device__ __forceinline__ void convert_weights(const Params& p, int layer, unsigned char* lds) {
  float* sT = (float*)lds;
  for (int it = blockIdx.x * 4; it < CV_ALL; it += gridDim.x * 4) convert_item4(p, layer, it, sT);
  __syncthreads();
}

__device__ __forceinline__ void norm_phase(const Params& p, int layer, int which  ) {
  int tid_l = threadIdx.x; asm volatile("" : "+v"(tid_l));
  const int lane = tid_l & 63, wv = tid_l >> 6;
  const float* nw = (which ? p.norm2_w : p.norm1_w) + layer * D;
  const float* mod = (const float*)(p.ws + WS_MOD) + (size_t)layer * 5 * 6144 + which * 3072;
  bf16_t* H = (bf16_t*)(p.ws + WS_H);
  for (int base = (blockIdx.x * 8 + wv) * 8; base < T; base += gridDim.x * 64) {
    const float* mr = mod + (size_t)cond_row(base) * 6144;
    f32x4 ws[4], sh[4];
#pragma unroll
    for (int j = 0; j < 4; ++j) { const int col = j * 256 + lane * 4; ws[j] = *(const f32x4*)(nw + col) * (*(const f32x4*)(mr + 1024 + col) + 1.f); sh[j] = *(const f32x4*)(mr + col); }
#pragma unroll
    for (int hf = 0; hf < 2; ++hf) {
      f32x4 v[4][4]; float ss[4];
#pragma unroll
      for (int i = 0; i < 4; ++i) { const int row = base + hf * 4 + i;
        const float* xr = which ? (const float*)(p.ws + WS_X) + (size_t)row * D : xrow_ptr(p, layer, row);
#pragma unroll
        for (int j = 0; j < 4; ++j) v[i][j] = *(const f32x4*)(xr + j * 256 + lane * 4); }
#pragma unroll
      for (int i = 0; i < 4; ++i) { float a = 0.f;
#pragma unroll
        for (int j = 0; j < 4; ++j) a += v[i][j].x * v[i][j].x + v[i][j].y * v[i][j].y + v[i][j].z * v[i][j].z + v[i][j].w * v[i][j].w;
        ss[i] = a; }
#pragma unroll
      for (int o = 32; o >= 1; o >>= 1) {
#pragma unroll
        for (int i = 0; i < 4; ++i) ss[i] += __shfl_xor(ss[i], o); }
#pragma unroll
      for (int i = 0; i < 4; ++i) { const int row = base + hf * 4 + i; const float rstd = rsqrtf(ss[i] * (1.f / D) + EPS);
#pragma unroll
        for (int j = 0; j < 4; ++j) { const f32x4 o = v[i][j] * rstd * ws[j] + sh[j];
          u32x2 pk; pk.x = pk2(o.x, o.y); pk.y = pk2(o.z, o.w);
          *(u32x2*)(H + (size_t)row * D + j * 256 + lane * 4) = pk; } }
    }
  }
}
__device__ __forceinline__ void final_norm(const Params& p) {
  int tid_l = threadIdx.x; asm volatile("" : "+v"(tid_l));
  const int lane = tid_l & 63, wv = tid_l >> 6;
  f32x4 w4[4];
#pragma unroll
  for (int j = 0; j < 4; ++j) w4[j] = *(const f32x4*)(p.final_norm_w + j * 256 + lane * 4);
  for (int base = (blockIdx.x * 8 + wv) * 8; base < T; base += gridDim.x * 64) {
#pragma unroll
    for (int hf = 0; hf < 2; ++hf) {
      f32x4 v[4][4]; float ss[4];
#pragma unroll
      for (int i = 0; i < 4; ++i) { const float* xr = (const float*)(p.ws + WS_X) + (size_t)(base + hf * 4 + i) * D;
#pragma unroll
        for (int j = 0; j < 4; ++j) v[i][j] = *(const f32x4*)(xr + j * 256 + lane * 4); }
#pragma unroll
      for (int i = 0; i < 4; ++i) { float a = 0.f;
#pragma unroll
        for (int j = 0; j < 4; ++j) a += v[i][j].x * v[i][j].x + v[i][j].y * v[i][j].y + v[i][j].z * v[i][j].z + v[i][j].w * v[i][j].w;
        ss[i] = a; }
#pragma unroll
      for (int o = 32; o >= 1; o >>= 1) {
#pragma unroll
        for (int i = 0; i < 4; ++i) ss[i] += __shfl_xor(ss[i], o); }
#pragma unroll
      for (int i = 0; i < 4; ++i) { const float rstd = rsqrtf(ss[i] * (1.f / D) + EPS);
#pragma unroll
        for (int j = 0; j < 4; ++j) *(f32x4*)(p.out + (size_t)(base + hf * 4 + i) * D + j * 256 + lane * 4) = v[i][j] * rstd * w4[j]; }
    }
  }
}

template <bool SSD>
__device__ __forceinline__ void decay_task(const Params& p, int layer, int seq, int head, int dir, unsigned char* lds) {
  constexpr int KD = SSD ? 128 : 64, LQ = KD + 8, NST = KD / 32;
  bf16_t* sQ = (bf16_t*)(lds + 64); bf16_t* sQs = sQ + 64 * LQ; bf16_t* sK = sQs + 64 * LQ; bf16_t* sSt = sK + 64 * LQ;
  bf16_t* sKdt = sSt + 64 * LQ; bf16_t* sVt = sKdt + KD * 72; bf16_t* sAtt = sVt + 64 * 72; bf16_t* sXs = sAtt + 64 * 72;
  float* sCum = (float*)(sXs + 64 * 72); float* sDt = sCum + 64; float* sCW = sDt + 64;
  const bf16_t* P = (const bf16_t*)(p.ws + WS_P);
  const float* gates = (const float*)(p.ws + WS_GATE);
  bf16_t* Odst = (bf16_t*)(p.ws + (dir ? WS_OB : WS_MIX));
  int tid_l = threadIdx.x; asm volatile("" : "+v"(tid_l));
  const int tid = tid_l, lane = tid & 63, w = tid >> 6, r = tid >> 3, sub = tid & 7;
  const bool sample = seq >= 32; const int L = sample ? 2048 : 256, seqbase = sample ? TP + (seq - 32) * 2048 : seq * 256, nch = L / 64;
  const int tr = w >> 1, tcs = (w & 1) * NST, tca = (w & 1) * 2;
  const int gidx = (layer * 2 + dir) * 4 + head;
  const int colbase = SSD ? 768 : 0;
  f32x4 accS[NST];
  if (sample) {
    const float* src = (SSD ? p.state_ssd : p.state_ret) + ((((size_t)(seq - 32) * 4 + layer) * 2 + dir) * 4 + head) * (KD * 64);
#pragma unroll
    for (int q = 0; q < NST; ++q) accS[q] = *(const f32x4*)(src + (16 * (tcs + q) + (lane & 15)) * 64 + 16 * tr + (lane >> 4) * 4);
  } else {
#pragma unroll
    for (int q = 0; q < NST; ++q) accS[q] = (f32x4){0.f, 0.f, 0.f, 0.f};
  }
  const float la_ret = SSD ? 0.f : p.ret_log_decay[gidx];
  const float Aneg = SSD ? -expf(p.ssd_A_log[gidx]) : 0.f, dtb = SSD ? p.ssd_dt_bias[gidx] : 0.f, Dh = SSD ? p.ssd_D[layer * 4 + head] : 0.f;
  const int grp = head >> 1;

  u32x4 xr[5][3]; float graw = 0.f;
  if constexpr (SSD) {
    const float* cw = p.ssd_conv_w + (size_t)layer * 3 * 768; const float* cb = p.ssd_conv_b + layer * 768;
    for (int i = tid; i < 1280; i += 512) { const int g5 = i >> 8, tap = (i >> 6) & 3, c = i & 63;
      const int chb = g5 == 0 ? head * 64 : (g5 <= 2 ? 256 + grp * 128 + (g5 - 1) * 64 : 512 + grp * 128 + (g5 - 3) * 64);
      sCW[i] = tap < 3 ? cw[tap * 768 + chb + c] : cb[chb + c]; }
    const int t0 = dir ? L - 1 - r : r, dm = t0 > 0 ? -NP : 0, dp = t0 < L - 1 ? NP : 0;
    const bf16_t* pr0 = P + (size_t)(seqbase + t0) * NP + C_SX + sub * 8;
    int gc[5]; gc[0] = head * 64; gc[1] = 256 + grp * 128; gc[2] = gc[1] + 64; gc[3] = 512 + grp * 128; gc[4] = gc[3] + 64;
#pragma unroll
    for (int g5 = 0; g5 < 5; ++g5) { const bf16_t* pc = pr0 + gc[g5]; xr[g5][0] = *(const u32x4*)(pc + dm); xr[g5][1] = *(const u32x4*)pc; xr[g5][2] = *(const u32x4*)(pc + dp); }
    if (tid < 64) { const int t2 = dir ? L - 1 - tid : tid; graw = gates[(size_t)(seqbase + t2) * 32 + 16 + dir * 4 + head]; }
    __syncthreads();
  }
  for (int n = 0; n < nch; ++n) {
    int tid_c = tid; asm volatile("" : "+v"(tid_c));
    const int tid = tid_c, lane = tid & 63, w = tid >> 6, r = tid >> 3, sub = tid & 7;
    const int tr = w >> 1, tcs = (w & 1) * NST, tca = (w & 1) * 2;
    const int pos = n * 64 + r, t = dir ? L - 1 - pos : pos;
    const bf16_t* prow = P + (size_t)(seqbase + t) * NP;
    float qv[KD / 64][8], kv[KD / 64][8], vv[8], xs[8];
    if constexpr (!SSD) {
      ld8(prow + C_RQ + head * 64 + sub * 8, qv[0]); ld8(prow + C_RK + head * 64 + sub * 8, kv[0]); ld8(prow + C_RV + head * 64 + sub * 8, vv);
#pragma unroll
      for (int e = 0; e < 8; ++e) kv[0][e] *= 0.125f;
      if (sample) {
        const float rowpos = (float)(t >> 6), colpos = (float)(t & 63);
#pragma unroll
        for (int e = 0; e < 8; ++e) {
          const int i = (sub & 3) * 8 + e;
          const float inv = exp2f(-(float)(i & 15) * (13.287712379549449f / 16.0f));
          const float ang = (i < 16 ? rowpos : colpos) * inv;
          float sn, cs; __sincosf(ang, &sn, &cs);
          const float oq = __shfl_xor(qv[0][e], 4), ok = __shfl_xor(kv[0][e], 4);
          if (sub < 4) { qv[0][e] = qv[0][e] * cs - oq * sn; kv[0][e] = kv[0][e] * cs - ok * sn; }
          else { qv[0][e] = oq * sn + qv[0][e] * cs; kv[0][e] = ok * sn + kv[0][e] * cs; }
        }
      }
    } else {
      const float m0 = t > 0 ? 1.f : 0.f, m2 = t < L - 1 ? 1.f : 0.f;
#pragma unroll
      for (int g5 = 0; g5 < 5; ++g5) {
        float x0[8], x1[8], x2[8], w0[8], w1[8], w2[8], bb[8];
        asm volatile("" : "+v"(xr[g5][0]), "+v"(xr[g5][1]), "+v"(xr[g5][2]));
        ldf8(sCW + (g5 * 4 + 0) * 64 + sub * 8, w0); ldf8(sCW + (g5 * 4 + 1) * 64 + sub * 8, w1); ldf8(sCW + (g5 * 4 + 2) * 64 + sub * 8, w2); ldf8(sCW + (g5 * 4 + 3) * 64 + sub * 8, bb);
        ld8v(xr[g5][0], x0); ld8v(xr[g5][1], x1); ld8v(xr[g5][2], x2);
#pragma unroll
        for (int e2 = 0; e2 < 8; ++e2) { float o = silu_f(bb[e2] + x1[e2] * w1[e2] + m0 * (x0[e2] * w0[e2]) + m2 * (x2[e2] * w2[e2]));
          asm volatile("" : "+v"(o));
          if (g5 == 0) xs[e2] = o; else if (g5 == 1) kv[0][e2] = o; else if (g5 == 2) kv[1][e2] = o; else if (g5 == 3) qv[0][e2] = o; else qv[1][e2] = o; }
        asm volatile("" ::: "memory");
      }
    }
    const float graw_c = graw;
    if constexpr (SSD) {
      if (n + 1 < nch) {
        const int pos1 = (n + 1) * 64 + r, t1 = dir ? L - 1 - pos1 : pos1, dm = t1 > 0 ? -NP : 0, dp = t1 < L - 1 ? NP : 0;
        const bf16_t* pr1 = P + (size_t)(seqbase + t1) * NP + C_SX + sub * 8;
        int gc[5]; gc[0] = head * 64; gc[1] = 256 + grp * 128; gc[2] = gc[1] + 64; gc[3] = 512 + grp * 128; gc[4] = gc[3] + 64;
#pragma unroll
        for (int g5 = 0; g5 < 5; ++g5) { const bf16_t* pc = pr1 + gc[g5]; xr[g5][0] = *(const u32x4*)(pc + dm); xr[g5][1] = *(const u32x4*)pc; xr[g5][2] = *(const u32x4*)(pc + dp); }
        if (tid < 64) { const int pos2 = (n + 1) * 64 + tid, t2 = dir ? L - 1 - pos2 : pos2; graw = gates[(size_t)(seqbase + t2) * 32 + 16 + dir * 4 + head]; }
      }
    }
    if (tid < 64) {
      float la, dtv = 0.f;
      if constexpr (SSD) {
        dtv = softplus_f(graw_c + dtb); la = Aneg * dtv;
      } else la = la_ret;
      float c = la;
#pragma unroll
      for (int o = 1; o < 64; o <<= 1) { const float y = __shfl_up(c, o); if (lane >= o) c += y; }
      sCum[tid] = c; sDt[tid] = dtv;
    }
    __syncthreads();
    const float cum_r = sCum[r], last = sCum[63];
    const float eq = __expf(cum_r), ek = __expf(last - cum_r);
    if constexpr (SSD) { const float dt_r = sDt[r];
#pragma unroll
      for (int e = 0; e < 8; ++e) vv[e] = xs[e] * dt_r;
      st8bf(sXs + r * 72 + sub * 8, xs); }
#pragma unroll
    for (int g = 0; g < KD / 64; ++g) {
      st8bf(sQ + r * LQ + g * 64 + sub * 8, qv[g]); st8bf(sK + r * LQ + g * 64 + sub * 8, kv[g]);
      float qs[8];
#pragma unroll
      for (int e = 0; e < 8; ++e) { qs[e] = qv[g][e] * eq; sKdt[(g * 64 + sub * 8 + e) * 72 + (r ^ ((sub >> 1) << 4))] = f2bf(kv[g][e] * ek); }
      st8bf(sQs + r * LQ + g * 64 + sub * 8, qs);
    }
#pragma unroll
    for (int e = 0; e < 8; ++e) sVt[(sub * 8 + e) * 72 + (r ^ ((sub >> 1) << 4))] = f2bf(vv[e]);
#pragma unroll
    for (int q = 0; q < NST; ++q)
#pragma unroll
      for (int j = 0; j < 4; ++j) sSt[(16 * tr + (lane >> 4) * 4 + j) * LQ + 16 * (tcs + q) + (lane & 15)] = f2bf(accS[q][j]);
    __syncthreads();
    f32x4 accO[2];
#pragma unroll
    for (int c2 = 0; c2 < 2; ++c2) {
      const int tc = tca + c2;
      f32x4 a = mma_tile(sQ + 16 * tr * LQ, LQ, sK + 16 * tc * LQ, LQ, KD, (f32x4){0.f, 0.f, 0.f, 0.f}, lane);
      accO[c2] = mma_tile(sQs + 16 * tr * LQ, LQ, sSt + 16 * tc * LQ, LQ, KD, (f32x4){0.f, 0.f, 0.f, 0.f}, lane);
      const int jj = 16 * tc + (lane & 15); const float cj = sCum[jj];
#pragma unroll
      for (int j = 0; j < 4; ++j) { const int i = 16 * tr + (lane >> 4) * 4 + j;
        const float val = (jj <= i) ? a[j] * __expf(sCum[i] - cj) : 0.f; sAtt[i * 72 + jj] = f2bf(val); }
    }
    __syncthreads();
#pragma unroll
    for (int c2 = 0; c2 < 2; ++c2) {
      const int tc = tca + c2;
      accO[c2] = mma_tile(sAtt + 16 * tr * 72, 72, sVt + 16 * tc * 72, 72, 64, accO[c2], lane, 0, (tc & 3) << 4);
      const int v = 16 * tc + (lane & 15);
#pragma unroll
      for (int j = 0; j < 4; ++j) { const int i = 16 * tr + (lane >> 4) * 4 + j;
        float o = accO[c2][j];
        if constexpr (SSD) { if (dir == 0) o += bf2f(sXs[i * 72 + v]) * Dh; }
        sQ[i * LQ + v] = f2bf(o); }
    }
    const float el = __expf(last);
#pragma unroll
    for (int q = 0; q < NST; ++q) { accS[q] = accS[q] * el; accS[q] = mma_tile(sVt + 16 * tr * 72, 72, sKdt + 16 * (tcs + q) * 72, 72, 64, accS[q], lane, (tr & 3) << 4, ((tcs + q) & 3) << 4); }
    __syncthreads();
    *(u32x4*)(Odst + (size_t)(seqbase + t) * D + colbase + head * 64 + sub * 8) = *(const u32x4*)(sQ + r * LQ + sub * 8);
  }
  if (!sample) {
    float* dst = p.out + (SSD ? OUT_SSD : OUT_RET) + ((((size_t)seq * 4 + layer) * 2 + dir) * 4 + head) * (KD * 64);
#pragma unroll
    for (int q = 0; q < NST; ++q) *(f32x4*)(dst + (16 * (tcs + q) + (lane & 15)) * 64 + 16 * tr + (lane >> 4) * 4) = accS[q];
  }
}

__device__ __forceinline__ void unpk8(u32x4 v, float (&o)[8]) {
  o[0] = __uint_as_float(v.x << 16); o[1] = __uint_as_float(v.x & 0xffff0000u); o[2] = __uint_as_float(v.y << 16); o[3] = __uint_as_float(v.y & 0xffff0000u);
  o[4] = __uint_as_float(v.z << 16); o[5] = __uint_as_float(v.z & 0xffff0000u); o[6] = __uint_as_float(v.w << 16); o[7] = __uint_as_float(v.w & 0xffff0000u); }
template <int OFF> __device__ __forceinline__ f32x4 lds_rd128(unsigned addr) { f32x4 v; asm volatile("ds_read_b128 %0, %1 offset:%2" : "=v"(v) : "v"(addr), "n"(OFF)); return v; }
template <int J> struct SolveStep {
  static __device__ __forceinline__ void run(f32x2v (&rr2)[8], f32x4 (&Ac)[4], unsigned apaddr, int part) {
    constexpr int mj = J >> 2, pj = J & 3, ip = mj >> 1, ie = mj & 1;
    f32x4 An[4];
    if constexpr (J < 62) {
      An[0] = lds_rd128<(J + 1) * 272 + 0>(apaddr); An[1] = lds_rd128<(J + 1) * 272 + 16>(apaddr); An[2] = lds_rd128<(J + 1) * 272 + 32>(apaddr); An[3] = lds_rd128<(J + 1) * 272 + 48>(apaddr);
      asm volatile("s_waitcnt lgkmcnt(4)" : "+v"(Ac[0]), "+v"(Ac[1]), "+v"(Ac[2]), "+v"(Ac[3]));
    } else {
      asm volatile("s_waitcnt lgkmcnt(0)" : "+v"(Ac[0]), "+v"(Ac[1]), "+v"(Ac[2]), "+v"(Ac[3]));
    }
    const float xj = __int_as_float(__builtin_amdgcn_mov_dpp(__float_as_int(rr2[ip][ie]), pj * 0x55, 0xf, 0xf, false));
    rr2[ip][ie] -= (part > pj ? Ac[mj >> 2][mj & 3] : 0.f) * xj;
    if constexpr (ie == 0) rr2[ip][1] -= Ac[(mj + 1) >> 2][(mj + 1) & 3] * xj;
    const f32x2v x2 = (f32x2v){xj, xj};
#pragma unroll
    for (int i = ip + 1; i < 8; ++i) {
      const f32x2v a2 = (i & 1) ? __builtin_shufflevector(Ac[i >> 1], Ac[i >> 1], 2, 3) : __builtin_shufflevector(Ac[i >> 1], Ac[i >> 1], 0, 1);
      rr2[i] = rr2[i] - a2 * x2;
    }
    if constexpr (J < 62) SolveStep<J + 1>::run(rr2, An, apaddr, part);
  }
};
template <int K> __device__ __forceinline__ float quad_bcast(float v) { return __int_as_float(__builtin_amdgcn_mov_dpp(__float_as_int(v), K * 0x55, 0xf, 0xf, false)); }
__device__ __forceinline__ void gdn_task(const Params& p, int layer, int seq, int head, int dir, unsigned char* lds) {
  constexpr int LQ = 72;
  bf16_t* sQ = (bf16_t*)(lds + 64); bf16_t* sQs = sQ + 64 * LQ; bf16_t* sK = sQs + 64 * LQ; bf16_t* sSt = sK + 64 * LQ;
  bf16_t* sKdt = sSt + 64 * LQ; bf16_t* sAtt = sKdt + 64 * LQ; bf16_t* sVNt = sAtt + 64 * LQ; bf16_t* sW = sVNt + 64 * LQ;
  float* sA = (float*)(sW + 64 * LQ);
  float* sR = sA + 64 * 68;
  float* sCum = sR + 64 * 132; float* sBeta = sCum + 64; float* sCW = sBeta + 64;
  const bf16_t* P = (const bf16_t*)(p.ws + WS_P);
  const float* gates = (const float*)(p.ws + WS_GATE);
  bf16_t* Odst = (bf16_t*)(p.ws + (dir ? WS_OB : WS_MIX));
  int tid_l = threadIdx.x; asm volatile("" : "+v"(tid_l));
  const int tid0 = tid_l;
  const bool sample = seq >= 32; const int L = sample ? 2048 : 256, seqbase = sample ? TP + (seq - 32) * 2048 : seq * 256, nch = L / 64;
  int tr, tca, lane;
  { const int w0 = tid0 >> 6; tr = w0 >> 1; tca = (w0 & 1) * 2; lane = tid0 & 63; }
  const int gidx = (layer * 2 + dir) * 4 + head;
  f32x4 accS[2];
  if (sample) {
    const float* src = p.state_gdn + ((((size_t)(seq - 32) * 4 + layer) * 2 + dir) * 4 + head) * 4096;
#pragma unroll
    for (int q = 0; q < 2; ++q) accS[q] = *(const f32x4*)(src + (16 * (tca + q) + (lane & 15)) * 64 + 16 * tr + (lane >> 4) * 4);
  } else {
#pragma unroll
    for (int q = 0; q < 2; ++q) accS[q] = (f32x4){0.f, 0.f, 0.f, 0.f};
  }
  const float Aneg = -expf(p.gdn_A_log[gidx]), dtb = p.gdn_dt_bias[gidx];
  const float* cw = p.gdn_conv_w + (size_t)layer * 3 * 768;

  const bf16_t* Pseq = P + (size_t)seqbase * NP + C_GQ + head * 64;
  for (int i = tid0; i < 576; i += 512) { const int a3 = i / 192, tap = (i % 192) >> 6, c = i & 63; sCW[i] = cw[tap * 768 + a3 * 256 + head * 64 + c]; }
  u32x4 xr[3][3]; float ga = 0.f, gb = 0.f;
  { const int r0 = tid0 >> 3, pos0 = r0, t0 = dir ? L - 1 - pos0 : pos0, tm = t0 > 0 ? t0 - 1 : 0, tp = t0 < L - 1 ? t0 + 1 : L - 1;
    const bf16_t* pb = Pseq + (tid0 & 7) * 8;
#pragma unroll
    for (int a3 = 0; a3 < 3; ++a3) { xr[a3][0] = *(const u32x4*)(pb + (size_t)tm * NP + a3 * 256); xr[a3][1] = *(const u32x4*)(pb + (size_t)t0 * NP + a3 * 256); xr[a3][2] = *(const u32x4*)(pb + (size_t)tp * NP + a3 * 256); }
    if (tid0 < 64) { const int t2 = dir ? L - 1 - tid0 : tid0; const float* gr = gates + (size_t)(seqbase + t2) * 32; ga = gr[dir * 4 + head]; gb = gr[8 + dir * 4 + head]; } }
  __syncthreads();
  for (int n = 0; n < nch; ++n) {
    int tid_c = tid0; asm volatile("" : "+v"(tid_c));
    const int tid = tid_c, r = tid >> 3, sub = tid & 7;
    lane = tid & 63; { const int w1 = tid >> 6; tr = w1 >> 1; tca = (w1 & 1) * 2; }
    const int pos = n * 64 + r, t = dir ? L - 1 - pos : pos;
    float qv[8], kv[8], vv[8];
    { const float m0 = t > 0 ? 1.f : 0.f, m2 = t < L - 1 ? 1.f : 0.f;
#pragma unroll
      for (int a3 = 0; a3 < 3; ++a3) {
        float x0[8], x1[8], x2[8], w0[8], w1[8], w2[8];
        unpk8(xr[a3][0], x0); unpk8(xr[a3][1], x1); unpk8(xr[a3][2], x2);
        ldf8(sCW + (a3 * 3 + 0) * 64 + sub * 8, w0); ldf8(sCW + (a3 * 3 + 1) * 64 + sub * 8, w1); ldf8(sCW + (a3 * 3 + 2) * 64 + sub * 8, w2);
#pragma unroll
        for (int e2 = 0; e2 < 8; ++e2) { const float o = x1[e2] * w1[e2] + m0 * (x0[e2] * w0[e2]) + m2 * (x2[e2] * w2[e2]); if (a3 == 0) qv[e2] = o; else if (a3 == 1) kv[e2] = o; else vv[e2] = o; }
      } }
    const float ga_c = ga, gb_c = gb;
    if (n + 1 < nch) {
      const int pos1 = (n + 1) * 64 + r, t1 = dir ? L - 1 - pos1 : pos1, tm = t1 > 0 ? t1 - 1 : 0, tp = t1 < L - 1 ? t1 + 1 : L - 1;
      const bf16_t* pb = Pseq + sub * 8;
#pragma unroll
      for (int a3 = 0; a3 < 3; ++a3) { xr[a3][0] = *(const u32x4*)(pb + (size_t)tm * NP + a3 * 256); xr[a3][1] = *(const u32x4*)(pb + (size_t)t1 * NP + a3 * 256); xr[a3][2] = *(const u32x4*)(pb + (size_t)tp * NP + a3 * 256); }
      if (tid < 64) { const int pos2 = (n + 1) * 64 + tid, t2 = dir ? L - 1 - pos2 : pos2; const float* gr = gates + (size_t)(seqbase + t2) * 32; ga = gr[dir * 4 + head]; gb = gr[8 + dir * 4 + head]; }
    }
    float sq = 0.f, sk = 0.f;
#pragma unroll
    for (int e = 0; e < 8; ++e) { qv[e] = silu_f(qv[e]); kv[e] = silu_f(kv[e]); vv[e] = silu_f(vv[e]); sq += qv[e] * qv[e]; sk += kv[e] * kv[e]; }
    sq += __shfl_xor(sq, 1); sq += __shfl_xor(sq, 2); sq += __shfl_xor(sq, 4);
    sk += __shfl_xor(sk, 1); sk += __shfl_xor(sk, 2); sk += __shfl_xor(sk, 4);
    const float rq = rsqrtf(sq + EPS) * 0.125f, rk = rsqrtf(sk + EPS);
#pragma unroll
    for (int e = 0; e < 8; ++e) { qv[e] *= rq; kv[e] *= rk; }
    if (tid < 64) {
      const float la = Aneg * softplus_f(ga_c + dtb);
      float c = la;
#pragma unroll
      for (int o = 1; o < 64; o <<= 1) { const float y = __shfl_up(c, o); if (lane >= o) c += y; }
      sCum[tid] = c; sBeta[tid] = sigmoid_f(gb_c);
    }
    __syncthreads();
    const float cum_r = sCum[r], last = sCum[63], beta_r = sBeta[r];
    const float eq = __expf(cum_r), ek = __expf(last - cum_r);
    st8bf(sQ + r * LQ + sub * 8, qv); st8bf(sK + r * LQ + sub * 8, kv);
    { float qs[8];
#pragma unroll
      for (int e = 0; e < 8; ++e) { qs[e] = qv[e] * eq; sKdt[(sub * 8 + e) * LQ + (r ^ ((sub >> 1) << 4))] = f2bf(kv[e] * ek);
        sR[r * 132 + sub * 8 + e] = kv[e] * (beta_r * eq); sR[r * 132 + 64 + sub * 8 + e] = vv[e] * beta_r; }
      st8bf(sQs + r * LQ + sub * 8, qs); }
#pragma unroll
    for (int q = 0; q < 2; ++q)
#pragma unroll
      for (int j = 0; j < 4; ++j) sSt[(16 * tr + (lane >> 4) * 4 + j) * LQ + 16 * (tca + q) + (lane & 15)] = f2bf(accS[q][j]);
    __syncthreads();
    f32x4 accO[2];
#pragma unroll
    for (int c2 = 0; c2 < 2; ++c2) {
      const int tc = tca + c2;
      const f32x4 kk = mma_tile(sK + 16 * tr * LQ, LQ, sK + 16 * tc * LQ, LQ, 64, (f32x4){0.f, 0.f, 0.f, 0.f}, lane);
      const f32x4 qk = mma_tile(sQ + 16 * tr * LQ, LQ, sK + 16 * tc * LQ, LQ, 64, (f32x4){0.f, 0.f, 0.f, 0.f}, lane);
      accO[c2] = mma_tile(sQs + 16 * tr * LQ, LQ, sSt + 16 * tc * LQ, LQ, 64, (f32x4){0.f, 0.f, 0.f, 0.f}, lane);
      const int jj = 16 * tc + (lane & 15); const float cj = sCum[jj];
#pragma unroll
      for (int j = 0; j < 4; ++j) { const int i = 16 * tr + (lane >> 4) * 4 + j;
        const float dec = (jj <= i) ? __expf(sCum[i] - cj) : 0.f;
        sA[jj * 68 + (i & 3) * 16 + (i >> 2)] = (jj < i) ? kk[j] * dec * sBeta[i] : 0.f;
        sAtt[i * LQ + jj] = f2bf(qk[j] * dec); }
    }
    __syncthreads();
    {
      int tid_s = tid0; asm volatile("" : "+v"(tid_s));
      const int col = tid_s >> 2, part = tid_s & 3;
      float* rb = sR + part * 132 + col;
      const unsigned apaddr = (unsigned)(size_t)(XLAS float*)(sA + part * 16);
      f32x2v rr2[8];
#pragma unroll
      for (int m = 0; m < 16; ++m) rr2[m >> 1][m & 1] = rb[m * 528];
      asm volatile("s_waitcnt lgkmcnt(0)" ::: "memory");
      f32x4 A0[4];
      A0[0] = lds_rd128<0>(apaddr); A0[1] = lds_rd128<16>(apaddr); A0[2] = lds_rd128<32>(apaddr); A0[3] = lds_rd128<48>(apaddr);
      SolveStep<0>::run(rr2, A0, apaddr, part);
      float rr[16];
#pragma unroll
      for (int m = 0; m < 16; ++m) rr[m] = rr2[m >> 1][m & 1];
      if (col < 64) {
        bf16_t* wb = sW + part * LQ + col;
#pragma unroll
        for (int m = 0; m < 16; ++m) wb[m * 4 * LQ] = f2bf(rr[m]);
      } else {
#pragma unroll
        for (int m = 0; m < 16; ++m) rb[m * 528] = rr[m];
      }
    }
    __syncthreads();
    { int tid_p = tid0; asm volatile("" : "+v"(tid_p)); lane = tid_p & 63; const int w2 = tid_p >> 6; tr = w2 >> 1; tca = (w2 & 1) * 2; }
#pragma unroll
    for (int c2 = 0; c2 < 2; ++c2) {
      const int tc = tca + c2;
      const f32x4 ws = mma_tile(sW + 16 * tr * LQ, LQ, sSt + 16 * tc * LQ, LQ, 64, (f32x4){0.f, 0.f, 0.f, 0.f}, lane);
      const int v = 16 * tc + (lane & 15);
#pragma unroll
      for (int j = 0; j < 4; ++j) { const int cI = 16 * tr + (lane >> 4) * 4 + j; sVNt[v * LQ + cI] = f2bf(sR[cI * 132 + 64 + v] - ws[j]); }
    }
    __syncthreads();
#pragma unroll
    for (int c2 = 0; c2 < 2; ++c2) {
      const int tc = tca + c2;
      accO[c2] = mma_tile(sAtt + 16 * tr * LQ, LQ, sVNt + 16 * tc * LQ, LQ, 64, accO[c2], lane);
      const int v = 16 * tc + (lane & 15);
#pragma unroll
      for (int j = 0; j < 4; ++j) { const int i = 16 * tr + (lane >> 4) * 4 + j;
        sQ[i * LQ + v] = f2bf(accO[c2][j]); }
    }
    const float el = __expf(last);
#pragma unroll
    for (int q = 0; q < 2; ++q) { accS[q] = accS[q] * el; accS[q] = mma_tile(sVNt + 16 * tr * LQ, LQ, sKdt + 16 * (tca + q) * LQ, LQ, 64, accS[q], lane, 0, ((tca + q) & 3) << 4); }
    __syncthreads();
    { int tid_o = tid0; asm volatile("" : "+v"(tid_o)); const int ro = tid_o >> 3, so = tid_o & 7, po = n * 64 + ro, to = dir ? L - 1 - po : po;
      *(u32x4*)(Odst + (size_t)(seqbase + to) * D + 512 + head * 64 + so * 8) = *(const u32x4*)(sQ + ro * LQ + so * 8); }
  }
  if (!sample) {
    float* dst = p.out + OUT_GDN + ((((size_t)seq * 4 + layer) * 2 + dir) * 4 + head) * 4096;
#pragma unroll
    for (int q = 0; q < 2; ++q) *(f32x4*)(dst + (16 * (tca + q) + (lane & 15)) * 64 + 16 * tr + (lane >> 4) * 4) = accS[q];
  }
}

__device__ __forceinline__ void unpk4(u32x2 v, float (&o)[4]) { o[0] = __uint_as_float(v.x << 16); o[1] = __uint_as_float(v.x & 0xffff0000u); o[2] = __uint_as_float(v.y << 16); o[3] = __uint_as_float(v.y & 0xffff0000u); }
__device__ __forceinline__ void hy1_task(const Params& p, int layer, int g, unsigned char* lds) {
  const bf16_t* P = (const bf16_t*)(p.ws + WS_P);
  bf16_t* Ut = (bf16_t*)(p.ws + WS_U); bf16_t* X0t = (bf16_t*)(p.ws + WS_X0);
  bf16_t* sTu = (bf16_t*)(lds + 64); bf16_t* sTx = sTu + 256 * 72;
  int tid_l = threadIdx.x; asm volatile("" : "+v"(tid_l));
  const int tid = tid_l, r = tid >> 3, sub = tid & 7;
  const int row = g * 64 + r;
  const bool sample = row >= TP; const int L = sample ? 2048 : 256, t = sample ? (row - TP) & 2047 : row & 255;
  const bf16_t* prow = P + (size_t)row * NP + C_HY;
  const float* cw = p.hy_conv_w + (size_t)layer * 3 * 768; const float* cb = p.hy_conv_b + layer * 768;
#pragma unroll
  for (int q = 0; q < 4; ++q) {
    const int ch = q * 64 + sub * 8;
    float x0[8], x1[8], v[8];
    conv8(prow + ch, t, L, cw + ch, cb + ch, x0); conv8(prow + 256 + ch, t, L, cw + 256 + ch, cb + 256 + ch, x1); conv8(prow + 512 + ch, t, L, cw + 512 + ch, cb + 512 + ch, v);
#pragma unroll
    for (int e = 0; e < 8; ++e) { sTu[(ch + e) * 72 + (r ^ ((sub >> 1) << 4))] = f2bf(v[e] * x1[e]); sTx[(ch + e) * 72 + (r ^ ((sub >> 1) << 4))] = f2bf(x0[e]); }
  }
  __syncthreads();
  const int c = tid >> 1, h = tid & 1;
#pragma unroll
  for (int i = 0; i < 4; ++i) {
    *(u32x4*)(Ut + (size_t)c * TS + g * 64 + h * 32 + i * 8) = *(const u32x4*)(sTu + c * 72 + ((h * 32 + i * 8) ^ (((c >> 4) & 3) << 4)));
    *(u32x4*)(X0t + (size_t)c * TS + g * 64 + h * 32 + i * 8) = *(const u32x4*)(sTx + c * 72 + ((h * 32 + i * 8) ^ (((c >> 4) & 3) << 4)));
  }
}

template <bool SAMPLE>
__device__ __forceinline__ void hy2_task(const Params& p, int layer, int c, unsigned char* lds) {
  constexpr int L = SAMPLE ? 2048 : 256, GL = 2 * L + 8, CSE = SAMPLE ? 4112 : 528, NE = L / 32;
  const int rowbase = SAMPLE ? TP : 0;
  bf16_t* sU = (bf16_t*)(lds + 64);
  bf16_t* sG = sU + 8192;
  bf16_t* sRaw = sG + 8 * CSE;
  int tid_l = threadIdx.x; asm volatile("" : "+v"(tid_l));
  const int tid = tid_l, lane = tid & 63, w = tid >> 6, q = lane >> 4, n = lane & 15;
  const bf16_t* Uc = (const bf16_t*)(p.ws + WS_U) + (size_t)c * TS + rowbase;
  const bf16_t* Gc = (const bf16_t*)(p.ws + WS_TAPS) + ((size_t)layer * 256 + c) * GT_CH + (SAMPLE ? GT_SOFF : 0);
#pragma unroll
  for (int i = 0; i < 2; ++i) *(u32x4*)(sU + (tid + i * 512) * 8) = *(const u32x4*)(Uc + (tid + i * 512) * 8);
  for (int v8 = tid; v8 < (GL + 8) / 8; v8 += 512) {
    u32x4 gv = *(const u32x4*)(Gc + v8 * 8);
    if (v8 == 0) gv.x &= 0xffff0000u;
    if (v8 * 8 >= 2 * L) gv = (u32x4){0u, 0u, 0u, 0u};
    *(u32x4*)(sRaw + v8 * 8) = gv;
  }
  __syncthreads();
  for (int idx = tid; idx < CSE; idx += 512) {
#pragma unroll
    for (int a = 0; a < 8; ++a) sG[a * CSE + idx] = (idx + a < GL + 8) ? sRaw[idx + a] : (bf16_t)0;
  }
  __syncthreads();
  f32x4 acc[2][2];
#pragma unroll
  for (int g = 0; g < 2; ++g)
#pragma unroll
    for (int rh = 0; rh < 2; ++rh) acc[g][rh] = (f32x4){0.f, 0.f, 0.f, 0.f};
  const int dlo = SAMPLE ? 8 * w - 63 : w - 7, dhi = SAMPLE ? 8 * w + 7 : w;
#pragma unroll 2
  for (int dp = dlo; dp <= dhi; ++dp) {
    bf16x8 fa[2];
#pragma unroll
    for (int rh = 0; rh < 2; ++rh) { const int m0 = L - 32 * dp - (16 * rh + n) + 8 * q; fa[rh] = *(const bf16x8*)(sG + (m0 & 7) * CSE + (m0 & ~7)); }
#pragma unroll
    for (int g = 0; g < 2; ++g) {
      const int a = SAMPLE ? 8 * w + 4 * g + (n >> 2) : w, b = SAMPLE ? (n & 3) : 16 * g + n;
      const int e = a - dp;
      bf16x8 fb = (bf16x8){0, 0, 0, 0, 0, 0, 0, 0};
      if ((unsigned)e < (unsigned)NE) fb = *(const bf16x8*)(sU + b * L + 32 * e + 8 * q);
      acc[g][0] = __builtin_amdgcn_mfma_f32_16x16x32_bf16(fa[0], fb, acc[g][0], 0, 0, 0);
      acc[g][1] = __builtin_amdgcn_mfma_f32_16x16x32_bf16(fa[1], fb, acc[g][1], 0, 0, 0);
    }
  }
  const float hb = p.hy_bias[layer * 256 + c];
  bf16_t* Yc = (bf16_t*)(p.ws + WS_Y) + (size_t)c * TS + rowbase;
  const bf16_t* Xc = (const bf16_t*)(p.ws + WS_X0) + (size_t)c * TS + rowbase;
#pragma unroll
  for (int g = 0; g < 2; ++g) {
    const int a = SAMPLE ? 8 * w + 4 * g + (n >> 2) : w, b = SAMPLE ? (n & 3) : 16 * g + n;
#pragma unroll
    for (int rh = 0; rh < 2; ++rh) {
      const int lrow = b * L + 32 * a + 16 * rh + q * 4;
      float u[4], x0[4];
      unpk4(*(const u32x2*)(sU + lrow), u); unpk4(*(const u32x2*)(Xc + lrow), x0);
      u32x2 o; o.x = pk2(x0[0] * (acc[g][rh][0] + u[0] * hb), x0[1] * (acc[g][rh][1] + u[1] * hb)); o.y = pk2(x0[2] * (acc[g][rh][2] + u[2] * hb), x0[3] * (acc[g][rh][3] + u[3] * hb));
      *(u32x2*)(Yc + lrow) = o;
    }
  }
}

__device__ __forceinline__ void finalize_rows(const Params& p, int layer, unsigned char* lds) {
  const bf16_t* P = (const bf16_t*)(p.ws + WS_P);
  bf16_t* MIX = (bf16_t*)(p.ws + WS_MIX); const bf16_t* OB = (const bf16_t*)(p.ws + WS_OB);
  const bf16_t* Yt = (const bf16_t*)(p.ws + WS_Y);
  bf16_t* sY = (bf16_t*)(lds + 64);
  int tid_l = threadIdx.x; asm volatile("" : "+v"(tid_l));
  const int tid = tid_l, lane = tid & 63, wv = tid >> 6, c4 = lane * 4;
  const f32x4 w_ret = *(const f32x4*)(p.ret_norm_w + layer * 256 + c4), w_hy = *(const f32x4*)(p.hy_norm_w + layer * 256 + c4);
  const f32x4 w_gdn = *(const f32x4*)(p.gdn_norm_w + layer * 256 + c4), w_ssd = *(const f32x4*)(p.ssd_norm_w + layer * 256 + c4);
  for (int tile = blockIdx.x; tile < T / 64; tile += gridDim.x) {
    __syncthreads();
    { const int c = tid >> 1, h = tid & 1;
#pragma unroll
      for (int i = 0; i < 4; ++i) *(u32x4*)(sY + c * 72 + h * 32 + i * 8) = *(const u32x4*)(Yt + (size_t)c * TS + tile * 64 + h * 32 + i * 8); }
    __syncthreads();
#pragma unroll 2
    for (int rr = 0; rr < 8; ++rr) {
      const int rl = wv * 8 + rr, row = tile * 64 + rl;
      bf16_t* mr = MIX + (size_t)row * D + c4; const bf16_t* br = OB + (size_t)row * D + c4; const bf16_t* pr = P + (size_t)row * NP + c4;
      const u32x2 m0 = *(const u32x2*)mr, m2 = *(const u32x2*)(mr + 512), m3 = *(const u32x2*)(mr + 768);
      const u32x2 b0 = *(const u32x2*)br, b2 = *(const u32x2*)(br + 512), b3 = *(const u32x2*)(br + 768);
      const u32x2 g0 = *(const u32x2*)(pr + C_RG), g2 = *(const u32x2*)(pr + C_GZ), g3 = *(const u32x2*)(pr + C_SZ);
      float a[4], b[4], g[4], o[4];
      u32x2 r0, r1, r2, r3;
      { unpk4(m0, a); unpk4(b0, b); unpk4(g0, g); float ss = 0.f;
#pragma unroll
        for (int e = 0; e < 4; ++e) { o[e] = a[e] + b[e]; ss += o[e] * o[e]; }
        ss += __shfl_xor(ss, 1); ss += __shfl_xor(ss, 2); ss += __shfl_xor(ss, 4); ss += __shfl_xor(ss, 8);
        const float rstd = rsqrtf(ss * (1.f / 64.f) + EPS);
        r0.x = pk2(o[0] * rstd * w_ret.x * silu_f(g[0]), o[1] * rstd * w_ret.y * silu_f(g[1])); r0.y = pk2(o[2] * rstd * w_ret.z * silu_f(g[2]), o[3] * rstd * w_ret.w * silu_f(g[3])); }
      {
#pragma unroll
        for (int e = 0; e < 4; ++e) o[e] = bf2f(sY[(c4 + e) * 72 + rl]);
        const float ss = o[0] * o[0] + o[1] * o[1] + o[2] * o[2] + o[3] * o[3];
        const float rstd = rsqrtf(wave_sum(ss) * (1.f / 256.f) + EPS);
        r1.x = pk2(o[0] * rstd * w_hy.x, o[1] * rstd * w_hy.y); r1.y = pk2(o[2] * rstd * w_hy.z, o[3] * rstd * w_hy.w); }
      { unpk4(m2, a); unpk4(b2, b); unpk4(g2, g); float ss = 0.f;
#pragma unroll
        for (int e = 0; e < 4; ++e) { o[e] = a[e] + b[e]; ss += o[e] * o[e]; }
        ss += __shfl_xor(ss, 1); ss += __shfl_xor(ss, 2); ss += __shfl_xor(ss, 4); ss += __shfl_xor(ss, 8);
        const float rstd = rsqrtf(ss * (1.f / 64.f) + EPS);
        r2.x = pk2(o[0] * rstd * w_gdn.x * silu_f(g[0]), o[1] * rstd * w_gdn.y * silu_f(g[1])); r2.y = pk2(o[2] * rstd * w_gdn.z * silu_f(g[2]), o[3] * rstd * w_gdn.w * silu_f(g[3])); }
      { unpk4(m3, a); unpk4(b3, b); unpk4(g3, g); float ss = 0.f;
#pragma unroll
        for (int e = 0; e < 4; ++e) { o[e] = (a[e] + b[e]) * silu_f(g[e]); ss += o[e] * o[e]; }
        ss += __shfl_xor(ss, 1); ss += __shfl_xor(ss, 2); ss += __shfl_xor(ss, 4); ss += __shfl_xor(ss, 8); ss += __shfl_xor(ss, 16);
        const float rstd = rsqrtf(ss * (1.f / 128.f) + EPS);
        r3.x = pk2(o[0] * rstd * w_ssd.x, o[1] * rstd * w_ssd.y); r3.y = pk2(o[2] * rstd * w_ssd.z, o[3] * rstd * w_ssd.w); }
      *(u32x2*)mr = r0; *(u32x2*)(mr + 256) = r1; *(u32x2*)(mr + 512) = r2; *(u32x2*)(mr + 768) = r3;
    }
  }
}

__global__ void __launch_bounds__(512) fwd_mega(Params p) {
  cg::grid_group grid = cg::this_grid();
  extern __shared__ __attribute__((aligned(16))) unsigned char lds[];
  PG8_LAS unsigned char* ldsl = (PG8_LAS unsigned char*)lds;
  int* slot = (int*)lds;
#ifdef X_REP_ALL
  unsigned* ctr0 = (unsigned*)(p.ws + WS_CTR);
#else
  unsigned* ctr = (unsigned*)(p.ws + WS_CTR);
#endif
  const bf16_t* Hb = (const bf16_t*)(p.ws + WS_H);
  bf16_t* Pb = (bf16_t*)(p.ws + WS_P);
  float* Xb = (float*)(p.ws + WS_X);
  const float* mod = (const float*)(p.ws + WS_MOD);

  volatile XLAS unsigned* xst = (volatile XLAS unsigned*)(ldsl + 147456 - 16);
  if (threadIdx.x == 0) { xst[0] = 0u; xst[1] = 0u; }
  __syncthreads();
  phase0(p, lds + 64);
  grid.sync();
  const XcdBarrier xb = xcd_barrier_post((unsigned*)(p.ws + WS_BAR), xst);
#ifdef X_REP_XB
  for (int i = 0; i < 40; ++i) xcd_barrier(xb);
#endif
  for (int layer = 0; layer < NL; ++layer) {
#ifdef X_REP_ALL
    for (int rep = 0; rep < 2; ++rep) {
    unsigned* ctr = ctr0 + rep * 32;
#endif
    if (layer == 0) convert_weights(p, layer, lds + 64);
    norm_phase(p, layer, 0);
    xcd_barrier(xb);
    { pg8::Gemm g{Hb, (const bf16_t*)(p.ws + (size_t)(layer & 1) * WBUF + WS_WIN), T, NP, D}; pg8::StaticOrder S; S.init(T, NP, gridDim.x, blockIdx.x);
      EpiP E{Pb, (float*)(p.ws + WS_GATE)}; pg8::gemm_phase<EpiP, pg8::StaticOrder>(ldsl, g, S, E, nullptr); }
    xcd_barrier(xb);
    { unsigned* q = ctr + layer * 16;
      if (blockIdx.x < 96) {
        const int id = blockIdx.x;
        const int mixer = id >> 5, rem = id & 31, seq = 32 + (rem >> 3), head = (rem >> 1) & 3, dir = rem & 1;
        if (mixer == 0) gdn_task(p, layer, seq, head, dir, lds);
        if (mixer == 1) decay_task<true>(p, layer, seq, head, dir, lds);
        if (mixer == 2) decay_task<false>(p, layer, seq, head, dir, lds);
      }
      const int s0 = (blockIdx.x >> 4) % 5;
      for (int i = 0; i < 5; ++i) {
        const int ty = (s0 + i) % 5;
        const int cnt = ty == 4 ? (layer + 1 < NL ? CV_ALL / 8 : 0) : 256;
        for (;;) {
          const int id = next_task(q + 2 + ty, slot);
          if (id >= cnt) break;
          if (ty == 0) {
            hy1_task(p, layer, id, lds);
            __threadfence(); __syncthreads();
            if (threadIdx.x == 0) __hip_atomic_fetch_add(q + 1, 1u, __ATOMIC_RELEASE, __HIP_MEMORY_SCOPE_AGENT);
          } else if (ty == 4) {
            convert_item4(p, layer + 1, id * 8, (float*)(lds + 64)); convert_item4(p, layer + 1, id * 8 + 4, (float*)(lds + 64));
          } else {
            const int seq = id >> 3, head = (id >> 1) & 3, dir = id & 1;
            if (ty == 1) gdn_task(p, layer, seq, head, dir, lds);
            if (ty == 2) decay_task<true>(p, layer, seq, head, dir, lds);
            if (ty == 3) decay_task<false>(p, layer, seq, head, dir, lds);
          }
        }
      }
      if (threadIdx.x == 0) { while (__hip_atomic_load(q + 1, __ATOMIC_ACQUIRE, __HIP_MEMORY_SCOPE_AGENT) < 256u) __builtin_amdgcn_s_sleep(8); }
      __syncthreads(); __threadfence();
      for (;;) { const int id = next_task(q + 7, slot); if (id >= 256) break; hy2_task<true>(p, layer, id, lds); }
      for (;;) { const int id = next_task(q + 8, slot); if (id >= 256) break; hy2_task<false>(p, layer, id, lds); }
    }
    xcd_barrier(xb);
    finalize_rows(p, layer, lds);
    xcd_barrier(xb);
#ifdef X_REP_ALL
    }
#endif
    { pg8::Gemm g{(const bf16_t*)(p.ws + WS_MIX), (const bf16_t*)(p.ws + (size_t)(layer & 1) * WBUF + WS_WOUT), T, D, D}; pg8::StaticOrder S; S.init(T, D, gridDim.x, blockIdx.x);
      EpiRes E{layer == 0 ? p.x_prompt : Xb, layer == 0 ? p.x_sample : Xb + (size_t)TP * D, Xb, mod + (size_t)layer * 5 * 6144 + 2048};
      pg8::gemm_phase<EpiRes, pg8::StaticOrder>(ldsl, g, S, E, nullptr);
#if defined(X_REP_G24) || defined(X_REP_ALL)
      EpiRes E2 = E; E2.xout = (float*)(p.ws + WS_P); pg8::gemm_phase<EpiRes, pg8::StaticOrder>(ldsl, g, S, E2, nullptr);
#endif
    }
    xcd_barrier(xb);
#ifdef X_REP_ALL
    for (int rep2 = 0; rep2 < 2; ++rep2) {
#endif
    norm_phase(p, layer, 1);
    xcd_barrier(xb);
    { pg8::Gemm g{Hb, (const bf16_t*)(p.ws + (size_t)(layer & 1) * WBUF + WS_W1), T, 4096, D}; pg8::StaticOrder S; S.init(T, 4096, gridDim.x, blockIdx.x);
      EpiRelu2 E{Pb}; pg8::gemm_phase<EpiRelu2, pg8::StaticOrder>(ldsl, g, S, E, nullptr); }
    xcd_barrier(xb);
#ifdef X_REP_ALL
    }
#endif
    { pg8::Gemm g{Pb, (const bf16_t*)(p.ws + (size_t)(layer & 1) * WBUF + WS_W2), T, D, 4096}; pg8::StaticOrder S; S.init(T, D, gridDim.x, blockIdx.x);
      EpiRes E{Xb, Xb + (size_t)TP * D, Xb, mod + (size_t)layer * 5 * 6144 + 5120};
#if defined(X_REP_G24) || defined(X_REP_ALL)
      { EpiRes E2 = E; E2.xout = (float*)(p.ws + WS_MIX); pg8::gemm_phase<EpiRes, pg8::StaticOrder>(ldsl, g, S, E2, nullptr); }
#endif
      pg8::gemm_phase<EpiRes, pg8::StaticOrder>(ldsl, g, S, E, nullptr); }
    xcd_barrier(xb);
  }
  final_norm(p);
}

extern "C" void kernel_launch(void* const* d_in, const int* in_sizes, int n_in, void* d_out, int out_size,
                              void* d_ws, size_t ws_size, hipStream_t stream) {
  constexpr size_t kDynLds = 144 * 1024;
  static int grid_blocks = 0;
  if (!grid_blocks) {
    int dev = 0, cus = 0, per_cu = 0;
    (void)hipGetDevice(&dev);
    (void)hipDeviceGetAttribute(&cus, hipDeviceAttributeMultiprocessorCount, dev);
    (void)hipFuncSetAttribute((const void*)fwd_mega, hipFuncAttributeMaxDynamicSharedMemorySize, (int)kDynLds);
    (void)hipOccupancyMaxActiveBlocksPerMultiprocessor(&per_cu, (const void*)fwd_mega, 512, kDynLds);
    grid_blocks = cus > 0 ? cus : 256;
    if (n_in != 38 || ws_size < WS_END || out_size != 33554432) { fprintf(stderr, "kernel_launch: unexpected sizes n_in %d ws %zu out %d\n", n_in, ws_size, out_size); grid_blocks = -1; }
  }
  if (grid_blocks < 0) return;
  Params p{};
  const float** pp = (const float**)&p;
  for (int i = 0; i < 38; ++i) pp[i] = (const float*)d_in[i];
  p.out = (float*)d_out; p.ws = (unsigned char*)d_ws;
  void* args[] = {&p};
  hipError_t e = hipLaunchCooperativeKernel((const void*)fwd_mega, dim3(grid_blocks), dim3(512), args, kDynLds, stream);
  if (e != hipSuccess) fprintf(stderr, "cooperative launch failed: %s (grid %d)\n", hipGetErrorString(e), grid_blocks);
}
```
